# Optimizing an MI355X kernel written in HIP

```python
import jax, jax.numpy as jnp
from jax import lax
import numpy as np

D_MODEL = 1024
BATCH = 16
SEQ = 4096
DEPTH = 4

N_HEADS = 16
HEAD_DIM = D_MODEL // N_HEADS
D_FF = -(-8 * D_MODEL // (3 * 256)) * 256
N_A_LAYERS = DEPTH // 2
N_B_LAYERS = DEPTH - N_A_LAYERS
BLOCK = 128
ROPE_THETA = 10000.0
NORM_EPS = 1e-6
DILATED_BRANCHES = ((128, 1), (512, 4), (2048, 16))

kernel_name = "yoco_stickbreak_dilated_hybrid"


def _rmsnorm(h, g):
    hf = h.astype(jnp.float32)
    y = hf * lax.rsqrt(jnp.mean(hf * hf, axis=-1, keepdims=True) + NORM_EPS)
    return (y * g.astype(jnp.float32)).astype(h.dtype)


def _rope(a):
    s, d = a.shape[1], a.shape[3]
    inv_freq = ROPE_THETA ** (-jnp.arange(0, d, 2, dtype=jnp.float32) / d)
    ang = jnp.arange(s, dtype=jnp.float32)[:, None] * inv_freq[None, :]
    cos = jnp.cos(ang)[:, None, :]
    sin = jnp.sin(ang)[:, None, :]
    af = a.astype(jnp.float32)
    a1, a2 = af[..., : d // 2], af[..., d // 2:]
    return jnp.concatenate([a1 * cos - a2 * sin, a2 * cos + a1 * sin], axis=-1).astype(a.dtype)


def _swiglu(h, w_gate, w_up, w_down):
    return (jax.nn.silu(h @ w_gate) * (h @ w_up)) @ w_down


def _stick_breaking(q, k, v):
    b, s, h, d = q.shape
    nq = s // BLOCK
    scale = d ** -0.5
    kh = k.transpose(0, 2, 1, 3)
    vh = v.transpose(0, 2, 1, 3)
    qblk = q.reshape(b, nq, BLOCK, h, d).transpose(1, 0, 3, 2, 4)
    key_pos = jnp.arange(s)

    def one_block(args):
        qb, bi = args
        qpos = bi * BLOCK + jnp.arange(BLOCK)
        strict = key_pos[None, :] < qpos[:, None]
        z = jnp.einsum('bhqd,bhkd->bhqk', qb, kh).astype(jnp.float32) * scale
        log_stay = jnp.where(strict, jax.nn.log_sigmoid(-z), 0.0)
        log_after = lax.cumsum(log_stay, axis=3, reverse=True) - log_stay
        w = jnp.where(strict, jnp.exp(jax.nn.log_sigmoid(z) + log_after), 0.0)
        return jnp.einsum('bhqk,bhkd->bhqd', w, vh.astype(jnp.float32)).astype(q.dtype)

    out = lax.map(one_block, (qblk, jnp.arange(nq)))
    return out.transpose(1, 0, 3, 2, 4).reshape(b, s, h, d)


def _to_blocks(a, r):
    b, s, h, d = a.shape
    n = s // r
    nb = -(-n // BLOCK)
    a = a.reshape(b, n, r, h, d).transpose(0, 2, 3, 1, 4)
    a = jnp.pad(a, ((0, 0), (0, 0), (0, 0), (0, nb * BLOCK - n), (0, 0)))
    return a.reshape(b, r, h, nb, BLOCK, d)


def _from_blocks(a, s):
    b, r, h, nb, blk, e = a.shape
    n = s // r
    a = a.reshape(b, r, h, nb * blk, e)[:, :, :, :n]
    return a.transpose(0, 3, 1, 2, 4).reshape(b, s, h, e)


def _dilated_branch(qb, kb, vb, steps):
    nb = qb.shape[3]
    scale = qb.shape[-1] ** -0.5
    k_prev = jnp.concatenate([jnp.zeros_like(kb[:, :, :, :1]), kb[:, :, :, :-1]], axis=3)
    v_prev = jnp.concatenate([jnp.zeros_like(vb[:, :, :, :1]), vb[:, :, :, :-1]], axis=3)
    k_band = jnp.concatenate([k_prev, kb], axis=4)
    v_band = jnp.concatenate([v_prev, vb], axis=4)
    z = jnp.einsum('brhnqd,brhnkd->brhnqk', qb, k_band).astype(jnp.float32) * scale
    qi = jnp.arange(BLOCK)[:, None]
    kj = jnp.arange(2 * BLOCK)[None, :]
    dist = BLOCK + qi - kj
    key_idx = (jnp.arange(nb)[:, None, None] - 1) * BLOCK + kj[None]
    valid = (dist >= 0)[None] & (dist <= steps)[None] & (key_idx >= 0)
    z = jnp.where(valid, z, -jnp.inf)
    m = jnp.max(z, axis=-1, keepdims=True)
    p = jnp.exp(z - m)
    den = jnp.sum(p, axis=-1, keepdims=True)
    o = jnp.einsum('brhnqk,brhnkd->brhnqd', p, v_band.astype(jnp.float32)) / den
    lse = m + jnp.log(den)
    return o, lse


def _dilated_attention(q, kv_blocks):
    s = q.shape[1]
    outs, lses = [], []
    for (window, r), (kb, vb) in zip(DILATED_BRANCHES, kv_blocks):
        o, lse = _dilated_branch(_to_blocks(q, r), kb, vb, window // r)
        outs.append(_from_blocks(o, s))
        lses.append(_from_blocks(lse, s))
    wts = jax.nn.softmax(jnp.stack(lses, axis=0), axis=0)
    return jnp.sum(wts * jnp.stack(outs, axis=0), axis=0).astype(q.dtype)


def setup_inputs(seed: int = 0) -> dict:
    key = jax.random.key(seed)
    ks = jax.random.split(key, 14)
    d, f = D_MODEL, D_FF
    nrm = lambda k, shape, fan: jax.random.normal(k, shape, jnp.float32) * fan ** -0.5
    gain = lambda k, shape: 1.0 + 0.02 * jax.random.normal(k, shape, jnp.float32)
    return {
        "x": jax.random.normal(ks[0], (BATCH, SEQ, d), jnp.float32),
        "norm_mix": gain(ks[1], (DEPTH, d)),
        "w_qkv_a": nrm(ks[2], (N_A_LAYERS, d, 3 * d), d),
        "w_o_a": nrm(ks[3], (N_A_LAYERS, d, d), d),
        "norm_kv": gain(ks[4], (d,)),
        "w_kv": nrm(ks[5], (d, 2 * d), d),
        "w_q_b": nrm(ks[6], (N_B_LAYERS, d, d), d),
        "w_o_b": nrm(ks[7], (N_B_LAYERS, d, d), d),
        "norm_ffn": gain(ks[8], (DEPTH, d)),
        "w_gate": nrm(ks[9], (DEPTH, d, f), d),
        "w_up": nrm(ks[10], (DEPTH, d, f), d),
        "w_down": nrm(ks[11], (DEPTH, f, d), f),
        "norm_final": gain(ks[12], (d,)),
    }


def reference(x, norm_mix, w_qkv_a, w_o_a, norm_kv, w_kv, w_q_b, w_o_b,
              norm_ffn, w_gate, w_up, w_down, norm_final):
    b, s, d = x.shape
    h = x
    kv_blocks = None
    for layer in range(DEPTH):
        hn = _rmsnorm(h, norm_mix[layer])
        if layer < N_A_LAYERS:
            q, k, v = jnp.split(hn @ w_qkv_a[layer], 3, axis=-1)
            q = q.reshape(b, s, N_HEADS, HEAD_DIM)
            k = k.reshape(b, s, N_HEADS, HEAD_DIM)
            v = v.reshape(b, s, N_HEADS, HEAD_DIM)
            o = _stick_breaking(q, k, v).reshape(b, s, d)
            h = h + o @ w_o_a[layer]
        else:
            j = layer - N_A_LAYERS
            if layer == N_A_LAYERS:
                kv = _rmsnorm(h, norm_kv) @ w_kv
                ks_, vs_ = jnp.split(kv, 2, axis=-1)
                ks_ = _rope(ks_.reshape(b, s, N_HEADS, HEAD_DIM))
                vs_ = vs_.reshape(b, s, N_HEADS, HEAD_DIM)
                kv_blocks = tuple((_to_blocks(ks_, r), _to_blocks(vs_, r))
                                  for (_, r) in DILATED_BRANCHES)
            q = _rope((hn @ w_q_b[j]).reshape(b, s, N_HEADS, HEAD_DIM))
            o = _dilated_attention(q, kv_blocks).reshape(b, s, d)
            h = h + o @ w_o_b[j]
        h = h + _swiglu(_rmsnorm(h, norm_ffn[layer]), w_gate[layer], w_up[layer], w_down[layer])
    return _rmsnorm(h, norm_final)
```

```cpp
#include <hip/hip_runtime.h>
#include <hip/hip_cooperative_groups.h>
#include <cstdio>
#include <cstdint>
namespace cg = cooperative_groups;
namespace pg8 {
#define PG8_LAS __attribute__((address_space(3)))
typedef unsigned short bf16_t;
typedef short bf16x8 __attribute__((ext_vector_type(8)));
typedef float f32x4 __attribute__((ext_vector_type(4)));
typedef unsigned u32x4 __attribute__((ext_vector_type(4)));
constexpr int BM = 256, BK = 64, HALF = 128, HTB = HALF * BK * 2  , STAGE_BYTES = 8 * HTB, NXCD = 8, WGM = 8;

__host__ __device__ __forceinline__ int lds_byte(int r, int c) { const int st = (r >> 4) * 2 + (c >> 5), rr = r & 15, cc = c & 31, ob = rr * 64 + cc * 2; return st * 1024 + (ob ^ (((ob >> 9) & 1) << 5)); }
__host__ __device__ __forceinline__ void stage_rc(int b, int& R, int& C) { const int st = b / 1024, sb = b % 1024, swz = sb ^ (((sb >> 9) & 1) << 5); R = (st >> 1) * 16 + swz / 64; C = (st & 1) * 32 + (swz % 64) / 2; }
__host__ __device__ __forceinline__ int perm32(int rho) { const int n = rho >> 4, i = rho & 15; return 8 * (i >> 2) + 4 * n + (i & 3); }

struct Unit { int pm, pn; };
struct Gemm { const bf16_t* A; const bf16_t* Bt; int M, N, K; };

struct StaticOrder {
    int nM, nN, nwg, G, c;
    __host__ __device__ void init(int M, int N, int G_, int c_) { nM = M / BM; nN = N / BM; nwg = nM * nN; G = G_; c = c_; }
    __host__ __device__ bool next(int i, Unit& u) const {
        const long L = (long)i * G + c; if (L >= nwg) return false;
        int wgid = (int)L; { const int q = nwg / NXCD, r = nwg % NXCD, xcd = wgid % NXCD, off = wgid / NXCD; wgid = (xcd < r ? xcd * (q + 1) : r * (q + 1) + (xcd - r) * q) + off; }
        const int nig = WGM * nN, gid = wgid / nig, fm = gid * WGM, gsz = (nM - fm) < WGM ? (nM - fm) : WGM;
        u.pm = fm + ((wgid % nig) % gsz); u.pn = (wgid % nig) / gsz; return true;
    }
    __device__ __forceinline__ void a_ready(const Unit&) const {}
    __device__ __forceinline__ void done(const Unit&) const {}
};

typedef unsigned u32x2 __attribute__((ext_vector_type(2)));
__device__ __forceinline__ unsigned cvt_pk_bf16(float lo, float hi) { unsigned r; asm volatile("v_cvt_pk_bf16_f32 %0, %1, %2" : "=v"(r) : "v"(lo), "v"(hi)); return r; }
constexpr float NORM_EPS = 1e-6f;
constexpr float QSCALE = 0.125f * 1.4426950408889634f;
__device__ __forceinline__ float row_rstd(const float* ssq, size_t row) {
    const f32x4* p = (const f32x4*)(ssq + row * 16); const f32x4 a = p[0], b = p[1], c = p[2], d = p[3];
    const float t = ((a[0] + a[1]) + (a[2] + a[3])) + ((b[0] + b[1]) + (b[2] + b[3])) + ((c[0] + c[1]) + (c[2] + c[3])) + ((d[0] + d[1]) + (d[2] + d[3]));
    return __builtin_amdgcn_rsqf(t * (1.0f / 1024.0f) + NORM_EPS);
}
__device__ __forceinline__ float row_ssq4(const float* ssq, size_t row, int fq) { const f32x4 a = ((const f32x4*)(ssq + row * 16))[fq]; return (a[0] + a[1]) + (a[2] + a[3]); }
__device__ __forceinline__ float rstd_fin(float t) { t += __shfl_xor(t, 16); t += __shfl_xor(t, 32); return __builtin_amdgcn_rsqf(t * (1.0f / 1024.0f) + NORM_EPS); }
template <int VMODE> struct EpiQKV {
    static constexpr bool PERM = true, AFTER_DRAIN = false, PERM_A = (VMODE == 0); static constexpr int vmode = VMODE, rope_on = VMODE, RM = PERM_A ? 1 : 16, RF = PERM_A ? 4 : 1;
    bf16_t* Q; bf16_t* Kb; bf16_t* Vt; const float* ssq; const float* rope;
    __device__ __forceinline__ void operator()(const f32x4 (&acc)[2][2][4][2], const Unit& u, int wr, int wc, int fr, int fq) const {
        asm volatile("" : "+v"(fr), "+v"(fq));
        const int type = u.pn >> 2, head = (u.pn & 3) * 4 + wc;
        const int b = u.pm >> 4, s0 = (u.pm & 15) * 256 + wr * 64 + RF * fr;
        const size_t row0 = (size_t)u.pm * 256 + wr * 64 + RF * fr;
        if (type < 2) {
            bf16_t* base = (type == 0) ? Q : Kb; const float sc = (type == 0) ? QSCALE : 1.0f;
            float rs[8];
#pragma unroll
            for (int t = 0; t < 8; ++t) rs[t] = row_ssq4(ssq, row0 + (t >> 2) * 128 + (t & 3) * RM, fq);
#pragma unroll
            for (int t = 0; t < 8; ++t) rs[t] = rstd_fin(rs[t]) * sc;
            f32x4 cs[2][2], sn[2][2];
            if (rope_on) { const float* rp = rope + (size_t)s0 * 64 + 8 * fq;
#pragma unroll
                for (int n = 0; n < 2; ++n) { cs[0][n] = *(const f32x4*)(rp + 4 * n); sn[0][n] = *(const f32x4*)(rp + 32 + 4 * n); } }
#pragma unroll
            for (int t = 0; t < 8; ++t) {
                const int ai = t >> 2, m = t & 3, cur = t & 1, nxt = cur ^ 1;
                const size_t row = row0 + ai * 128 + m * RM; const int s = s0 + ai * 128 + m * RM; const float f = rs[t];
                if (rope_on && t < 7) { const float* rp = rope + (size_t)(s0 + ((t + 1) >> 2) * 128 + ((t + 1) & 3) * RM) * 64 + 8 * fq;
#pragma unroll
                    for (int n = 0; n < 2; ++n) { cs[nxt][n] = *(const f32x4*)(rp + 4 * n); sn[nxt][n] = *(const f32x4*)(rp + 32 + 4 * n); } }
                f32x4 lo[2], hi[2];
#pragma unroll
                for (int n = 0; n < 2; ++n) { lo[n] = acc[ai][0][m][n] * f; hi[n] = acc[ai][1][m][n] * f; }
                if (rope_on) {
#pragma unroll
                    for (int n = 0; n < 2; ++n) { const f32x4 a1 = lo[n], a2 = hi[n]; lo[n] = a1 * cs[cur][n] - a2 * sn[cur][n]; hi[n] = a2 * cs[cur][n] + a1 * sn[cur][n]; } }
                bf16_t* dst; int hoff;
                if (type == 1 && vmode == 1) { dst = base + ((size_t)((b * 16 + head) * 16 + fr) * 32 + (u.pm & 15) * 2 + ai) * 512 + (fq * 8 + 4 * wr + m) * 8; hoff = 256; }
                else if (type == 1) {
                    const int kk = s & 31, mrow = 8 * ((kk >> 2) & 3) + 4 * (kk >> 4) + (kk & 3);
                    dst = base + ((size_t)(b * 16 + head) * 128 + (s >> 5)) * 2048 + (fq >> 1) * 512 + ((fq & 1) * 32 + mrow) * 8; hoff = 1024; }
                else { dst = base + row * 1024 + head * 64 + 8 * fq; hoff = 32; }
                u32x4 w; w.x = cvt_pk_bf16(lo[0][0], lo[0][1]); w.y = cvt_pk_bf16(lo[0][2], lo[0][3]); w.z = cvt_pk_bf16(lo[1][0], lo[1][1]); w.w = cvt_pk_bf16(lo[1][2], lo[1][3]);
                *(u32x4*)dst = w;
                w.x = cvt_pk_bf16(hi[0][0], hi[0][1]); w.y = cvt_pk_bf16(hi[0][2], hi[0][3]); w.z = cvt_pk_bf16(hi[1][0], hi[1][1]); w.w = cvt_pk_bf16(hi[1][2], hi[1][3]);
                *(u32x4*)(dst + hoff) = w;
                if (rope_on) asm volatile("" ::: "memory");
            }
        } else {
            bf16_t* vb = Vt + ((size_t)(b * 16 + head) * 64) * 4096;
            float rstd[2][4];
#pragma unroll
            for (int ai = 0; ai < 2; ++ai)
#pragma unroll
                for (int m = 0; m < 4; ++m) rstd[ai][m] = row_ssq4(ssq, row0 + ai * 128 + m * RM, fq);
#pragma unroll
            for (int ai = 0; ai < 2; ++ai)
#pragma unroll
                for (int m = 0; m < 4; ++m) rstd[ai][m] = rstd_fin(rstd[ai][m]);
#pragma unroll
            for (int bj = 0; bj < 2; ++bj)
#pragma unroll
                for (int n = 0; n < 2; ++n)
#pragma unroll
                    for (int i = 0; i < 4; ++i) {
#pragma unroll
                        for (int ai = 0; ai < 2; ++ai) {
                            const float v0 = acc[ai][bj][0][n][i] * rstd[ai][0], v1 = acc[ai][bj][1][n][i] * rstd[ai][1], v2 = acc[ai][bj][2][n][i] * rstd[ai][2], v3 = acc[ai][bj][3][n][i] * rstd[ai][3];
                            const unsigned p01 = cvt_pk_bf16(v0, v1), p23 = cvt_pk_bf16(v2, v3);
                            if (vmode == 0) {
                                u32x2 w; w.x = p01; w.y = p23;
                                *(u32x2*)(vb + (size_t)((u.pm & 15) * 8 + 4 * ai + 2 * wr + (fr >> 3)) * 2048 + ((bj * 2 + ((fr >> 1) & 1)) * 64 + ((fr >> 2) & 1) * 32 + 8 * fq + 4 * n + i) * 8 + 4 * (fr & 1)) = w; }
                            else { u32x2 w; w.x = p01; w.y = p23;
                                *(u32x2*)(vb + ((size_t)fr * 32 + (u.pm & 15) * 2 + ai) * 512 + (32 * bj + 8 * fq + 4 * n + i) * 8 + wr * 4) = w; }
                        }
                    }
        }
    }
};
struct EpiRes {
    static constexpr bool PERM = true, AFTER_DRAIN = false, PERM_A = false;
    bf16_t* hb; float* ssq;
    __device__ __forceinline__ void operator()(const f32x4 (&acc)[2][2][4][2], const Unit& u, int wr, int wc, int fr, int fq) const {
        asm volatile("" : "+v"(fr), "+v"(fq));
        const int c0 = u.pn * 256 + wc * 32 + 8 * fq; const size_t row0 = (size_t)u.pm * 256 + wr * 64 + fr;
        u32x4 old[2][2];
#pragma unroll
        for (int bj = 0; bj < 2; ++bj) old[0][bj] = *(const u32x4*)(hb + row0 * 1024 + c0 + bj * 128);
#pragma unroll
        for (int t = 0; t < 8; ++t) {
            const int ai = t >> 2, m = t & 3, cur = t & 1, nxt = cur ^ 1;
            const size_t row = row0 + ai * 128 + m * 16; float ss = 0.f;
            if (t < 7) { const size_t rn = row0 + ((t + 1) >> 2) * 128 + ((t + 1) & 3) * 16;
#pragma unroll
                for (int bj = 0; bj < 2; ++bj) old[nxt][bj] = *(const u32x4*)(hb + rn * 1024 + c0 + bj * 128); }
#pragma unroll
            for (int bj = 0; bj < 2; ++bj) { const size_t off = row * 1024 + c0 + bj * 128; const u32x4 o = old[cur][bj];
                f32x4 h0 = acc[ai][bj][m][0], h1 = acc[ai][bj][m][1];
                h0[0] += __uint_as_float(o.x << 16); h0[1] += __uint_as_float(o.x & 0xffff0000u); h0[2] += __uint_as_float(o.y << 16); h0[3] += __uint_as_float(o.y & 0xffff0000u);
                h1[0] += __uint_as_float(o.z << 16); h1[1] += __uint_as_float(o.z & 0xffff0000u); h1[2] += __uint_as_float(o.w << 16); h1[3] += __uint_as_float(o.w & 0xffff0000u);
                u32x4 w; w.x = cvt_pk_bf16(h0[0], h0[1]); w.y = cvt_pk_bf16(h0[2], h0[3]); w.z = cvt_pk_bf16(h1[0], h1[1]); w.w = cvt_pk_bf16(h1[2], h1[3]); *(u32x4*)(hb + off) = w;
                ss += ((h0[0] * h0[0] + h0[1] * h0[1]) + (h0[2] * h0[2] + h0[3] * h0[3])) + ((h1[0] * h1[0] + h1[1] * h1[1]) + (h1[2] * h1[2] + h1[3] * h1[3])); }
            ss += __shfl_xor(ss, 16); ss += __shfl_xor(ss, 32);
            if (fq == 0) ssq[row * 16 + u.pn * 4 + wc] = ss;
            asm volatile("" ::: "memory");
        }
    }
};
struct EpiSwiGLU {
    static constexpr bool PERM = true, AFTER_DRAIN = false, PERM_A = false;
    bf16_t* act; const float* ssq;
    __device__ __forceinline__ void operator()(const f32x4 (&acc)[2][2][4][2], const Unit& u, int wr, int wc, int fr, int fq) const {
        asm volatile("" : "+v"(fr), "+v"(fq));
        const int col0 = u.pn * 128 + wc * 32 + 8 * fq; const size_t row0 = (size_t)u.pm * 256 + wr * 64 + fr;
        float rsv[8];
#pragma unroll
        for (int t = 0; t < 8; ++t) rsv[t] = row_ssq4(ssq, row0 + (t >> 2) * 128 + (t & 3) * 16, fq);
#pragma unroll
        for (int t = 0; t < 8; ++t) rsv[t] = rstd_fin(rsv[t]);
#pragma unroll
        for (int ai = 0; ai < 2; ++ai)
#pragma unroll
            for (int m = 0; m < 4; ++m) {
                const size_t row = row0 + ai * 128 + m * 16; const float rs = rsv[ai * 4 + m];
                float o[8];
#pragma unroll
                for (int n = 0; n < 2; ++n)
#pragma unroll
                    for (int i = 0; i < 4; ++i) { const float g = acc[ai][0][m][n][i] * rs, up = acc[ai][1][m][n][i] * rs;
                        const float sg = __builtin_amdgcn_rcpf(1.0f + __builtin_amdgcn_exp2f(-1.4426950408889634f * g)); o[4 * n + i] = g * sg * up; }
                u32x4 w; w.x = cvt_pk_bf16(o[0], o[1]); w.y = cvt_pk_bf16(o[2], o[3]); w.z = cvt_pk_bf16(o[4], o[5]); w.w = cvt_pk_bf16(o[6], o[7]);
                __builtin_nontemporal_store(w, (u32x4*)(act + row * 2816 + col0));
            }
    }
};

template <class Epi, class Sched, bool ALIGN_EPI = false, bool SP2 = false>
__device__ __forceinline__ void gemm_phase(PG8_LAS unsigned char* lds, const Gemm g, const Sched& S, const Epi& E) {
    int tid_l = threadIdx.x; asm volatile("" : "+v"(tid_l)); const int tid = tid_l, wid = __builtin_amdgcn_readfirstlane(tid >> 6), lane = tid & 63, wr = wid >> 2, wc = wid & 3, fr = lane & 15, fq = lane >> 4;
    const int K = g.K, nt = K / BK;
    unsigned voffA[2], voffB[2];
#pragma unroll
    for (int i = 0; i < 2; ++i) { int R, C; stage_rc(tid * 16 + i * 8192, R, C); const int Rb = Epi::PERM ? ((R & ~31) + perm32(R & 31)) : R;
        const int Ra = Epi::PERM_A ? ((R & ~63) + 4 * (R & 15) + ((R >> 4) & 3)) : R;
        voffA[i] = (unsigned)(Ra * K + C) * 2u; voffB[i] = (unsigned)(Rb * K + C) * 2u; }
    const size_t kstep = (size_t)(BK * 2);
    const size_t hstep = (size_t)HALF * K * 2;
    const size_t tstep = 2 * hstep;
    const unsigned ldsw = (unsigned)wid * 1024u;
    const int aoff = lds_byte(wr * 64 + fr, fq * 8), boff = lds_byte(wc * 32 + fr, fq * 8);
#define PG8_SA(b, h) (((b) * 2 + (h)) * HTB)
#define PG8_SB(b, h) ((4 + (b) * 2 + (h)) * HTB)
#define PG8_STAGE(bufoff, gbase, voff) do { _Pragma("unroll") for (int _i = 0; _i < 2; ++_i) \
        __builtin_amdgcn_global_load_lds((const unsigned*)((const char*)(gbase) + (voff)[_i]), (PG8_LAS unsigned*)(lds + (bufoff) + ldsw + _i * 8192), 16, 0, 0); } while (0)
#define PG8_LDA(dst, b, h) do { _Pragma("unroll") for (int m = 0; m < 4; ++m) _Pragma("unroll") for (int k = 0; k < 2; ++k) dst[m][k] = *(const PG8_LAS bf16x8*)(lds + PG8_SA(b, h) + aoff + m * 2048 + k * 1024); } while (0)
#define PG8_LDB(dst, b, h) do { _Pragma("unroll") for (int n = 0; n < 2; ++n) _Pragma("unroll") for (int k = 0; k < 2; ++k) dst[n][k] = *(const PG8_LAS bf16x8*)(lds + PG8_SB(b, h) + boff + n * 2048 + k * 1024); } while (0)
#define PG8_MMA(ai, bj, At, Bt) do { __builtin_amdgcn_s_setprio(1); _Pragma("unroll") for (int m = 0; m < 4; ++m) _Pragma("unroll") for (int n = 0; n < 2; ++n) _Pragma("unroll") for (int k = 0; k < 2; ++k) \
        acc[ai][bj][m][n] = __builtin_amdgcn_mfma_f32_16x16x32_bf16(Bt[n][k], At[m][k], acc[ai][bj][m][n], 0, 0, 0); __builtin_amdgcn_s_setprio(0); } while (0)
#define PG8_WAIT_V(n) asm volatile("s_waitcnt vmcnt(" #n ")" ::: "memory")
#define PG8_WAIT_L(n) asm volatile("s_waitcnt lgkmcnt(" #n ")" ::: "memory")
#define PG8_BAR __builtin_amdgcn_s_barrier()
#define PG8_SCHED __builtin_amdgcn_sched_barrier(0)
    Unit cur, nxt; int ui = 0;
    if (!S.next(0, cur)) return;
    f32x4 acc[2][2][4][2];
#pragma unroll
    for (int a = 0; a < 2; ++a)
#pragma unroll
        for (int b = 0; b < 2; ++b)
#pragma unroll
            for (int m = 0; m < 4; ++m)
#pragma unroll
                for (int n = 0; n < 2; ++n) acc[a][b][m][n] = (f32x4){0.f, 0.f, 0.f, 0.f};
    bf16x8 At[4][2], B0[2][2], B1[2][2];
    const char* cA = (const char*)g.A + (size_t)cur.pm * tstep; const char* cB = (const char*)g.Bt + (size_t)cur.pn * tstep;
    S.a_ready(cur);
    if constexpr (SP2) {
        PG8_STAGE(PG8_SB(0, 0), cB, voffB); PG8_STAGE(PG8_SB(0, 1), cB + hstep, voffB); PG8_STAGE(PG8_SA(0, 0), cA, voffA); PG8_STAGE(PG8_SA(0, 1), cA + hstep, voffA);
        if (wr == 1) PG8_BAR;
        PG8_WAIT_V(2); PG8_BAR;
        PG8_STAGE(PG8_SB(1, 0), cB + kstep, voffB); PG8_STAGE(PG8_SA(1, 0), cA + kstep, voffA); PG8_STAGE(PG8_SB(1, 1), cB + hstep + kstep, voffB);
        PG8_WAIT_V(6); PG8_BAR;
    } else {
        PG8_STAGE(PG8_SB(0, 0), cB, voffB); PG8_STAGE(PG8_SA(0, 0), cA, voffA); PG8_STAGE(PG8_SB(0, 1), cB + hstep, voffB); PG8_STAGE(PG8_SA(0, 1), cA + hstep, voffA);
        if (wr == 1) PG8_BAR;
        PG8_WAIT_V(4); PG8_BAR;
        PG8_STAGE(PG8_SB(1, 0), cB + kstep, voffB); PG8_STAGE(PG8_SA(1, 0), cA + kstep, voffA); PG8_STAGE(PG8_SB(1, 1), cB + hstep + kstep, voffB);
        PG8_WAIT_V(6); PG8_BAR;
    }
    for (;;) {
        const bool has_next = S.next(ui + 1, nxt);
        const char* nA = has_next ? (const char*)g.A + (size_t)nxt.pm * tstep : cA; const char* nB = has_next ? (const char*)g.Bt + (size_t)nxt.pn * tstep : cB;
        for (int t = 0; t < nt; t += 2) {
            const bool last = (t == nt - 2);
            const char* a1 = cA + (size_t)(t + 1) * kstep;
            const char* a2 = last ? nA : cA + (size_t)(t + 2) * kstep; const char* b2 = last ? nB : cB + (size_t)(t + 2) * kstep;
            const char* a3 = a2 + kstep; const char* b3 = b2 + kstep;
            if (last && has_next) S.a_ready(nxt);
            if constexpr (SP2) {
            PG8_LDB(B0, 0, 0); PG8_LDB(B1, 0, 1); PG8_SCHED; PG8_LDA(At, 0, 0); PG8_STAGE(PG8_SA(1, 1), a1 + hstep, voffA);
            PG8_WAIT_V(8); PG8_WAIT_L(0); PG8_BAR; PG8_MMA(0, 0, At, B0); PG8_MMA(0, 1, At, B1); PG8_BAR; PG8_SCHED;
            PG8_LDA(At, 0, 1); PG8_STAGE(PG8_SB(0, 0), b2, voffB); PG8_STAGE(PG8_SB(0, 1), b2 + hstep, voffB); PG8_STAGE(PG8_SA(0, 0), a2, voffA);
            PG8_WAIT_V(8); PG8_WAIT_L(0); PG8_BAR; PG8_MMA(1, 0, At, B0); PG8_MMA(1, 1, At, B1); PG8_BAR; PG8_SCHED;
            PG8_LDB(B0, 1, 0); PG8_LDB(B1, 1, 1); PG8_SCHED; PG8_LDA(At, 1, 0); PG8_STAGE(PG8_SA(0, 1), a2 + hstep, voffA);
            PG8_WAIT_V(8); PG8_WAIT_L(0); PG8_BAR; PG8_MMA(0, 0, At, B0); PG8_MMA(0, 1, At, B1); PG8_BAR; PG8_SCHED;
            PG8_LDA(At, 1, 1); PG8_STAGE(PG8_SB(1, 0), b3, voffB); PG8_STAGE(PG8_SB(1, 1), b3 + hstep, voffB); PG8_STAGE(PG8_SA(1, 0), a3, voffA);
            PG8_WAIT_V(8); PG8_WAIT_L(0); PG8_BAR; PG8_MMA(1, 0, At, B0); PG8_MMA(1, 1, At, B1); PG8_BAR; PG8_SCHED;
            } else {
            PG8_LDB(B0, 0, 0); PG8_SCHED; PG8_LDA(At, 0, 0); PG8_STAGE(PG8_SA(1, 1), a1 + hstep, voffA);
            PG8_WAIT_L(8); PG8_BAR; PG8_WAIT_L(0); PG8_MMA(0, 0, At, B0); PG8_BAR; PG8_SCHED;
            PG8_LDB(B1, 0, 1); PG8_STAGE(PG8_SB(0, 0), b2, voffB);
            PG8_BAR; PG8_WAIT_L(0); PG8_MMA(0, 1, At, B1); PG8_BAR;
            PG8_LDA(At, 0, 1); PG8_STAGE(PG8_SA(0, 0), a2, voffA);
            PG8_BAR; PG8_WAIT_L(0); PG8_MMA(1, 0, At, B0); PG8_BAR; PG8_SCHED;
            PG8_STAGE(PG8_SB(0, 1), b2 + hstep, voffB);
            PG8_WAIT_V(6); PG8_BAR; PG8_MMA(1, 1, At, B1); PG8_BAR;
            PG8_LDB(B0, 1, 0); PG8_SCHED; PG8_LDA(At, 1, 0); PG8_STAGE(PG8_SA(0, 1), a2 + hstep, voffA);
            PG8_WAIT_L(8); PG8_BAR; PG8_WAIT_L(0); PG8_MMA(0, 0, At, B0); PG8_BAR; PG8_SCHED;
            PG8_LDB(B1, 1, 1); PG8_STAGE(PG8_SB(1, 0), b3, voffB);
            PG8_BAR; PG8_WAIT_L(0); PG8_MMA(0, 1, At, B1); PG8_BAR;
            PG8_LDA(At, 1, 1); PG8_STAGE(PG8_SA(1, 0), a3, voffA);
            PG8_BAR; PG8_WAIT_L(0); PG8_MMA(1, 0, At, B0); PG8_BAR; PG8_SCHED;
            PG8_STAGE(PG8_SB(1, 1), b3 + hstep, voffB);
            PG8_WAIT_V(6); PG8_BAR; PG8_MMA(1, 1, At, B1); PG8_BAR;
            }
        }
        if constexpr (ALIGN_EPI) { if (wr == 0) PG8_BAR; }
        if constexpr (!Epi::AFTER_DRAIN) { E(acc, cur, wr, wc, fr, fq); S.done(cur); }
        if (!has_next) break;
#pragma unroll
        for (int a = 0; a < 2; ++a)
#pragma unroll
            for (int b = 0; b < 2; ++b)
#pragma unroll
                for (int m = 0; m < 4; ++m)
#pragma unroll
                    for (int n = 0; n < 2; ++n) acc[a][b][m][n] = (f32x4){0.f, 0.f, 0.f, 0.f};
        cur = nxt; cA = nA; cB = nB; ++ui;
        if constexpr (ALIGN_EPI) { if (wr == 1) PG8_BAR; }
    }
    PG8_WAIT_V(0);
    if constexpr (!ALIGN_EPI) { if (wr == 0) PG8_BAR; }
    PG8_BAR;
    if constexpr (Epi::AFTER_DRAIN) { E.fused(acc, cur, wr, wc, fr, fq, lds, wid, lane); S.done(cur); }
#undef PG8_SA
#undef PG8_SB
#undef PG8_STAGE
#undef PG8_LDA
#undef PG8_LDB
#undef PG8_MMA
#undef PG8_WAIT_V
#undef PG8_WAIT_L
#undef PG8_BAR
#undef PG8_SCHED
}
}
using pg8::bf16_t; using pg8::bf16x8; using pg8::f32x4; using pg8::u32x4; using pg8::u32x2; using pg8::cvt_pk_bf16;
typedef float f32x16 __attribute__((ext_vector_type(16)));
#define LAS __attribute__((address_space(3)))
constexpr int DM = 1024, NBATCH = 16, SEQ = 4096, NH = 16, HD = 64, DFF = 2816, MTOK = NBATCH * SEQ, DEPTH = 4;
constexpr size_t MiB = 1u << 20;
constexpr size_t WS_SSQ = 0, WS_ROPE = 4 * MiB, WS_BAR = 6 * MiB, BAR_BYTES = 16384;
constexpr size_t WS_WQKV_A = 8 * MiB, WS_WO_A = 20 * MiB, WS_WB2 = 24 * MiB, WS_WB3 = 30 * MiB, WS_WO_B = 32 * MiB, WS_WGU = 36 * MiB, WS_WDN = 80 * MiB;
constexpr size_t WS_HB = 104 * MiB, WS_QO = 232 * MiB, WS_K = 360 * MiB, WS_VT = 488 * MiB, WS_ACT = 616 * MiB, WS_END = 968 * MiB;
constexpr size_t SZ_WQKV = (size_t)3072 * 1024 * 2, SZ_WSQ = (size_t)1024 * 1024 * 2, SZ_WGU = (size_t)5632 * 1024 * 2, SZ_WDN = (size_t)1024 * 2816 * 2;
constexpr int BARW_OFF = 155584;
constexpr int LDS_BYTES = 155648;
constexpr int NPHASE = 22;
#ifndef PROBE
#define PROBE 0
#endif

struct TJob { const float* src; const float* gain; bf16_t* dst; int ld, col0, ncols, K, dst_row0, map; };
struct Args { const float* in[13]; float* out; unsigned char* ws; int ph_lo, ph_hi; };
typedef const __attribute__((address_space(4))) Args* ArgsP;
constexpr int NJOBS = 21;
__device__ __forceinline__ int job_items(int j) { if (j < 6) return (j % 3 == 0) ? 16 * 96 : 16 * 32; if (j == 7) return 16 * 64; if (j < 9) return 16 * 32; return ((j - 9) % 3 == 2) ? 44 * 32 : 16 * 88; }
__device__ __forceinline__ TJob get_job(ArgsP ap, int j) {
    TJob J; unsigned char* ws = ap->ws;
    const float* norm_mix = ap->in[1]; const float* norm_ffn = ap->in[8];
    if (j < 6) { const int L = j / 3, k = j % 3;
        if (k == 0) { J.src = ap->in[2] + (size_t)L * 1024 * 3072; J.gain = norm_mix + L * 1024; J.dst = (bf16_t*)(ws + WS_WQKV_A + L * SZ_WQKV); J.ld = 3072; J.ncols = 3072; J.K = 1024; J.map = 1; }
        else if (k == 1) { J.src = ap->in[3] + (size_t)L * 1024 * 1024; J.gain = nullptr; J.dst = (bf16_t*)(ws + WS_WO_A + L * SZ_WSQ); J.ld = 1024; J.ncols = 1024; J.K = 1024; J.map = 0; }
        else { J.src = ap->in[7] + (size_t)L * 1024 * 1024; J.gain = nullptr; J.dst = (bf16_t*)(ws + WS_WO_B + L * SZ_WSQ); J.ld = 1024; J.ncols = 1024; J.K = 1024; J.map = 0; }
        J.col0 = 0; J.dst_row0 = 0; return J; }
    if (j == 6) { J.src = ap->in[6]; J.gain = norm_mix + 2 * 1024; J.dst = (bf16_t*)(ws + WS_WB2); J.ld = 1024; J.col0 = 0; J.ncols = 1024; J.K = 1024; J.dst_row0 = 0; J.map = 1; return J; }
    if (j == 7) { J.src = ap->in[5]; J.gain = ap->in[4]; J.dst = (bf16_t*)(ws + WS_WB2); J.ld = 2048; J.col0 = 0; J.ncols = 2048; J.K = 1024; J.dst_row0 = 1024; J.map = 1; return J; }
    if (j == 8) { J.src = ap->in[6] + (size_t)1024 * 1024; J.gain = norm_mix + 3 * 1024; J.dst = (bf16_t*)(ws + WS_WB3); J.ld = 1024; J.col0 = 0; J.ncols = 1024; J.K = 1024; J.dst_row0 = 0; J.map = 1; return J; }
    { const int L = (j - 9) / 3, k = (j - 9) % 3; J.col0 = 0; J.dst_row0 = 0;
        if (k == 0) { J.src = ap->in[9] + (size_t)L * 1024 * 2816; J.gain = norm_ffn + L * 1024; J.dst = (bf16_t*)(ws + WS_WGU + L * SZ_WGU); J.ld = 2816; J.ncols = 2816; J.K = 1024; J.map = 2; }
        else if (k == 1) { J.src = ap->in[10] + (size_t)L * 1024 * 2816; J.gain = norm_ffn + L * 1024; J.dst = (bf16_t*)(ws + WS_WGU + L * SZ_WGU); J.ld = 2816; J.ncols = 2816; J.K = 1024; J.map = 3; }
        else { J.src = ap->in[11] + (size_t)L * 2816 * 1024; J.gain = nullptr; J.dst = (bf16_t*)(ws + WS_WDN + L * SZ_WDN); J.ld = 1024; J.ncols = 1024; J.K = 2816; J.map = 0; }
        return J; }
}

__device__ __forceinline__ int map_col(int c, int map) {
    if (map == 1) { const int p = c >> 8, hh = (c >> 6) & 3, bj = (c >> 5) & 1, tt = c & 31; return (p << 8) + (bj << 7) + (hh << 5) + tt; }
    if (map == 2) return ((c >> 7) << 8) + (c & 127);
    if (map == 3) return ((c >> 7) << 8) + 128 + (c & 127);
    return c;
}
__device__ __forceinline__ void transpose_item(const TJob& J, LAS float* scr, int item, int lane) {
    const int nblk = J.ncols / 32, kb = item / nblk, nb = item % nblk, k0 = 64 * kb, n0 = 32 * nb;
#pragma unroll
    for (int i = 0; i < 8; ++i) { const int kk = 8 * i + (lane >> 3), ch = lane & 7; const float g = J.gain ? J.gain[k0 + kk] : 1.0f;
        const f32x4 v = __builtin_nontemporal_load((const f32x4*)(J.src + (size_t)(k0 + kk) * J.ld + J.col0 + n0 + 4 * ch));
        *(LAS f32x4*)(scr + kk * 36 + 4 * ch) = v * g; }
    asm volatile("s_waitcnt lgkmcnt(0)" ::: "memory");
    const int c = lane & 7; const int drow = J.dst_row0 + map_col(n0, J.map);
#pragma unroll
    for (int j = 0; j < 4; ++j) { const int n = (lane >> 3) + 8 * j; const LAS float* s = scr + (8 * c) * 36 + n;
        u32x4 o; o.x = cvt_pk_bf16(s[0 * 36], s[1 * 36]); o.y = cvt_pk_bf16(s[2 * 36], s[3 * 36]); o.z = cvt_pk_bf16(s[4 * 36], s[5 * 36]); o.w = cvt_pk_bf16(s[6 * 36], s[7 * 36]);
        *(u32x4*)(J.dst + (size_t)(drow + n) * J.K + k0 + 8 * c) = o; }
    asm volatile("s_waitcnt lgkmcnt(0)" ::: "memory");
}
__device__ __forceinline__ float wave_sum(float v) {
#pragma unroll
    for (int o = 1; o < 64; o <<= 1) v += __shfl_xor(v, o);
    return v;
}
__device__ __forceinline__ void prologue(ArgsP ap, LAS unsigned char* lds, int gw, int ngw, int wave, int lane) {
    LAS float* scr = (LAS float*)(lds + wave * 16384);
    int total = 0;
    for (int j = 0; j < NJOBS; ++j) total += job_items(j);
    for (int it = gw; it < total; it += ngw) {
        int r = it, j = 0;
        for (; j < NJOBS; ++j) { const int n = job_items(j); if (r < n) break; r -= n; }
        const TJob J = get_job(ap, j);
        transpose_item(J, scr, r, lane);
    }
    float* rope = (float*)(ap->ws + WS_ROPE);
    for (int e = gw * 64 + lane; e < SEQ * 32; e += ngw * 64) { const int s = e >> 5, j = e & 31;
        const float inv = __builtin_amdgcn_exp2f(-(float)j * 0.41524101186092033f);
        const float ang = (float)s * inv; double rev = (double)ang * 0.15915494309189535; rev -= __builtin_floor(rev); const float rf = (float)rev;
        rope[s * 64 + j] = __builtin_amdgcn_cosf(rf); rope[s * 64 + 32 + j] = __builtin_amdgcn_sinf(rf); }
    bf16_t* hb = (bf16_t*)(ap->ws + WS_HB); float* ssq = (float*)(ap->ws + WS_SSQ); const float* xin = ap->in[0];
    for (int row = gw; row < MTOK; row += ngw) {
        const f32x4* xr = (const f32x4*)(xin + (size_t)row * DM) + lane; float ss = 0.f; f32x4 v[4];
#pragma unroll
        for (int j = 0; j < 4; ++j) { v[j] = xr[64 * j]; ss += (v[j][0] * v[j][0] + v[j][1] * v[j][1]) + (v[j][2] * v[j][2] + v[j][3] * v[j][3]); }
        ss = wave_sum(ss);
        u32x2* o = (u32x2*)(hb + (size_t)row * DM) + lane;
#pragma unroll
        for (int j = 0; j < 4; ++j) { u32x2 w; w.x = cvt_pk_bf16(v[j][0], v[j][1]); w.y = cvt_pk_bf16(v[j][2], v[j][3]); o[64 * j] = w; }
        if (lane < 16) ssq[(size_t)row * 16 + lane] = (lane == 0) ? ss : 0.f;
    }
}
__device__ __forceinline__ void final_norm(ArgsP ap, int gw, int ngw, int lane) {
    const float* ssq = (const float*)(ap->ws + WS_SSQ); float* outp = ap->out; const float* nf = ap->in[12]; const bf16_t* hb = (const bf16_t*)(ap->ws + WS_HB);
    f32x4 g[4];
#pragma unroll
    for (int j = 0; j < 4; ++j) g[j] = ((const f32x4*)nf)[lane + 64 * j];
    for (int row = gw; row < MTOK; row += ngw) {
        const float rs = pg8::row_rstd(ssq, (size_t)row);
        const u32x2* hr = (const u32x2*)(hb + (size_t)row * DM) + lane; f32x4* xr = (f32x4*)(outp + (size_t)row * DM) + lane;
#pragma unroll
        for (int j = 0; j < 4; ++j) { const u32x2 o = hr[64 * j]; f32x4 v;
            v[0] = __uint_as_float(o.x << 16); v[1] = __uint_as_float(o.x & 0xffff0000u); v[2] = __uint_as_float(o.y << 16); v[3] = __uint_as_float(o.y & 0xffff0000u);
            xr[64 * j] = v * rs * g[j]; }
    }
}

__device__ __forceinline__ bf16x8 pack8(const float* w) {
    u32x4 p; p.x = cvt_pk_bf16(w[0], w[1]); p.y = cvt_pk_bf16(w[2], w[3]); p.z = cvt_pk_bf16(w[4], w[5]); p.w = cvt_pk_bf16(w[6], w[7]);
    return __builtin_bit_cast(bf16x8, p);
}
__device__ __forceinline__ void store_o(bf16_t* orow, const f32x16& o0, const f32x16& o1, float sc, int hi) {
#pragma unroll
    for (int g = 0; g < 4; ++g) {
        u32x2 w; w.x = cvt_pk_bf16(o0[4 * g] * sc, o0[4 * g + 1] * sc); w.y = cvt_pk_bf16(o0[4 * g + 2] * sc, o0[4 * g + 3] * sc); *(u32x2*)(orow + 8 * g + 4 * hi) = w;
        w.x = cvt_pk_bf16(o1[4 * g] * sc, o1[4 * g + 1] * sc); w.y = cvt_pk_bf16(o1[4 * g + 2] * sc, o1[4 * g + 3] * sc); *(u32x2*)(orow + 32 + 8 * g + 4 * hi) = w;
    }
}
constexpr int SCR_PITCH = 144, SCR_BYTES = 32 * SCR_PITCH, SCR_OFF = 40960;
__device__ __forceinline__ void rows_to_lds(LAS unsigned char* scr, const bf16_t* base, int t0, int ts, int lane) {
#pragma unroll
    for (int k = 0; k < 4; ++k) { const int row = 8 * k + (lane >> 3), ch = lane & 7; const u32x4 v = __builtin_nontemporal_load((const u32x4*)(base + (size_t)(t0 + ts * row) * DM + ch * 8)); *(LAS u32x4*)(scr + row * SCR_PITCH + ch * 16) = v; }
}
__device__ __forceinline__ void lds_to_rows(LAS unsigned char* scr, bf16_t* base, int t0, int ts, int lane) {
#pragma unroll
    for (int k = 0; k < 4; ++k) { const int row = 8 * k + (lane >> 3), ch = lane & 7; const u32x4 v = *(LAS u32x4*)(scr + row * SCR_PITCH + ch * 16); __builtin_nontemporal_store(v, (u32x4*)(base + (size_t)(t0 + ts * row) * DM + ch * 8)); }
}
__device__ __forceinline__ void o_to_lds(LAS unsigned char* scr, const f32x16& o0, const f32x16& o1, float sc, int r32, int hi) {
#pragma unroll
    for (int g = 0; g < 4; ++g) {
        u32x2 w; w.x = cvt_pk_bf16(o0[4 * g] * sc, o0[4 * g + 1] * sc); w.y = cvt_pk_bf16(o0[4 * g + 2] * sc, o0[4 * g + 3] * sc); *(LAS u32x2*)(scr + r32 * SCR_PITCH + (8 * g + 4 * hi) * 2) = w;
        w.x = cvt_pk_bf16(o1[4 * g] * sc, o1[4 * g + 1] * sc); w.y = cvt_pk_bf16(o1[4 * g + 2] * sc, o1[4 * g + 3] * sc); *(LAS u32x2*)(scr + r32 * SCR_PITCH + (32 + 8 * g + 4 * hi) * 2) = w;
    }
}
__device__ __forceinline__ void sb_unit(const bf16_t* Q, const bf16_t* Kb, const bf16_t* Vt, bf16_t* O, int bh, int qb, int lane, int cap = 1 << 30) {
    const int b = bh >> 4, h = bh & 15, r32 = lane & 31, hi = lane >> 5;
    const size_t rowbase = (size_t)b * SEQ;
    const bf16_t* qp = Q + (rowbase + qb * 32 + r32) * DM + h * HD + 8 * hi;
    bf16x8 qf[4];
#pragma unroll
    for (int s = 0; s < 4; ++s) qf[s] = *(const bf16x8*)(qp + 16 * s);
    const bf16_t* kp = Kb + (size_t)bh * (128 * 2048) + lane * 8;
    const bf16_t* vp = Vt + (size_t)bh * (128 * 2048) + lane * 8;
    f32x16 o0 = {}, o1 = {}; float P = 1.0f;
    bf16x8 kA[4], vA[4], kB[4], vB[4], kC[4], vC[4];
#define SB_LOAD(KF, VF, JT) do { { const int jt_ = (JT) < 0 ? 0 : (JT); const bf16_t* kt_ = kp + jt_ * 2048; const bf16_t* vt_ = vp + jt_ * 2048; \
        _Pragma("unroll") for (int s = 0; s < 4; ++s) { KF[s] = *(const bf16x8*)(kt_ + 512 * s); VF[s] = *(const bf16x8*)(vt_ + 512 * s); } } } while (0)
#define SB_STEP(KF, VF, JT) do { \
        f32x16 S = {}; \
        _Pragma("unroll") for (int s = 0; s < 4; ++s) S = __builtin_amdgcn_mfma_f32_32x32x16_bf16(KF[s], qf[s], S, 0, 0, 0); \
        float r[16]; const bool diag = ((JT) == qb); \
        _Pragma("unroll") for (int i = 0; i < 16; ++i) { float e = __builtin_amdgcn_exp2f(S[i]); if (diag && (16 * hi + i >= r32)) e = 0.f; r[i] = __builtin_amdgcn_rcpf(1.0f + e); } \
        const float t8a = ((r[8] * r[9]) * (r[10] * r[11])) * ((r[12] * r[13]) * (r[14] * r[15])), t8b = ((r[0] * r[1]) * (r[2] * r[3])) * ((r[4] * r[5]) * (r[6] * r[7])), tot = t8a * t8b; \
        auto rr = __builtin_amdgcn_permlane32_swap(__float_as_uint(tot), __float_as_uint(tot), false, false); \
        const float tot_lo = __uint_as_float(rr[0]), tot_hi = __uint_as_float(rr[1]); \
        float A = hi ? P : P * tot_hi; float B2 = A * t8a; P = P * tot_lo * tot_hi; float w[16];        \
        _Pragma("unroll") for (int i = 7; i >= 0; --i) { const float An = A * r[8 + i]; w[8 + i] = A - An; A = An; const float Bn = B2 * r[i]; w[i] = B2 - Bn; B2 = Bn; } \
        const bf16x8 p0 = pack8(w), p1 = pack8(w + 8); \
        o0 = __builtin_amdgcn_mfma_f32_32x32x16_bf16(VF[0], p0, o0, 0, 0, 0); o0 = __builtin_amdgcn_mfma_f32_32x32x16_bf16(VF[1], p1, o0, 0, 0, 0); \
        o1 = __builtin_amdgcn_mfma_f32_32x32x16_bf16(VF[2], p0, o1, 0, 0, 0); o1 = __builtin_amdgcn_mfma_f32_32x32x16_bf16(VF[3], p1, o1, 0, 0, 0); } while (0)
    SB_LOAD(kA, vA, qb); SB_LOAD(kB, vB, qb - 1);
    for (int jt = qb; jt >= 0 && jt > qb - cap; jt -= 3) {
        SB_LOAD(kC, vC, jt - 2); SB_STEP(kA, vA, jt);     if (jt - 1 < 0 || __ballot(P != 0.0f) == 0ull) break;
        SB_LOAD(kA, vA, jt - 3); SB_STEP(kB, vB, jt - 1); if (jt - 2 < 0 || __ballot(P != 0.0f) == 0ull) break;
        SB_LOAD(kB, vB, jt - 4); SB_STEP(kC, vC, jt - 2); if (__ballot(P != 0.0f) == 0ull) break;
    }
#undef SB_LOAD
#undef SB_STEP
    store_o(O + (rowbase + qb * 32 + r32) * DM + h * HD, o0, o1, 1.0f, hi);
}

struct DTile { int cb, cs, ibase, is, wr, valid; };
template <int MODE> __device__ __forceinline__ DTile dil_decode(int tt, int c, int ib) {
    DTile d;
    if (MODE == 0) { const int w = (ib >> 2) - 1 + (tt >> 2); d.cb = 4 * (tt & 3); d.cs = 1; d.ibase = 8 * w; d.is = 0; d.wr = 128; d.valid = w >= 0; }
    else if (tt < 5) { const int w = ib - 4 + tt; d.cb = c; d.cs = 0; d.ibase = 32 * w; d.is = 8; d.wr = 2048; d.valid = w >= 0; }
    else { const int w = 4 * ib - 4 + (tt - 5); d.cb = c & 3; d.cs = 4; d.ibase = 8 * w; d.is = 0; d.wr = 512; d.valid = w >= 0; }
    return d;
}
__device__ __forceinline__ void dil_load(const DTile& d, const bf16_t* kq, const bf16_t* vq, int rho_m, int j_m, int hi, bf16x8* kf, bf16x8* vf) {
    const int ib0 = d.valid ? d.ibase : 0;
    const bf16_t* kt = kq + (size_t)((d.cb + d.cs * rho_m) * 32 + ((ib0 + d.is * rho_m) >> 3)) * 512;
#pragma unroll
    for (int s = 0; s < 4; ++s) kf[s] = *(const bf16x8*)(kt + s * 128);
#pragma unroll
    for (int u = 0; u < 2; ++u) { const int rho = 2 * hi + u; const bf16_t* vt = vq + (size_t)((d.cb + d.cs * rho) * 32 + ((ib0 + d.is * rho) >> 3)) * 512;
        vf[u] = *(const bf16x8*)(vt); vf[2 + u] = *(const bf16x8*)(vt + 256); }
}
__device__ __forceinline__ void dil_load_u(const bf16_t* kbh, const bf16_t* vbh, unsigned sbase, unsigned kro, unsigned vro0, unsigned vro1, bf16x8* kf, bf16x8* vf) {
    const bf16_t* kt = kbh + sbase; const bf16_t* vt = vbh + sbase;
#pragma unroll
    for (int s = 0; s < 4; ++s) kf[s] = *(const bf16x8*)(kt + (kro + s * 128));
    vf[0] = *(const bf16x8*)(vt + vro0); vf[1] = *(const bf16x8*)(vt + vro1); vf[2] = *(const bf16x8*)(vt + (vro0 + 256)); vf[3] = *(const bf16x8*)(vt + (vro1 + 256));
}
template <int MODE> __device__ __forceinline__ void dil_unit(const bf16_t* Q, const bf16_t* Kb, const bf16_t* Vt, bf16_t* O, bf16_t* X1, float* LSE, int bh, int c, int ib, int lane, LAS unsigned char* scr, int ntcap = 64) {
    constexpr int NT = MODE == 0 ? 8 : 13;
    const int b = bh >> 4, h = bh & 15, r32 = lane & 31, hi = lane >> 5;
    const size_t rowbase = (size_t)b * SEQ;
    const int tq = MODE == 0 ? 32 * ib + r32 : c + 16 * (32 * ib + r32);
    const int t0 = MODE == 0 ? 32 * ib : c + 512 * ib, ts = MODE == 0 ? 1 : 16;
    rows_to_lds(scr, Q + rowbase * DM + h * HD, t0, ts, lane);
    bf16x8 qf[4];
#pragma unroll
    for (int s = 0; s < 4; ++s) qf[s] = *(LAS bf16x8*)(scr + r32 * SCR_PITCH + (2 * s + hi) * 16);
    const int u_m = (r32 >> 4) & 1, hi_m = (r32 >> 2) & 1, j_m = (r32 & 3) + 4 * ((r32 >> 3) & 1), rho_m = 2 * hi_m + u_m;
    const bf16_t* kq = Kb + (size_t)bh * (16 * 32 * 512) + (8 * hi + j_m) * 8;
    const bf16_t* vq = Vt + (size_t)bh * (16 * 32 * 512) + r32 * 8;
    f32x16 o0 = {}, o1 = {}; float mrun = -1e30f, l = 0.f;
    bf16x8 kA[4], vA[4], kB[4], vB[4], kC[4], vC[4];
    const bf16_t* kbh = Kb + (size_t)bh * (16 * 32 * 512); const bf16_t* vbh = Vt + (size_t)bh * (16 * 32 * 512);
    const unsigned kl_ = (unsigned)((8 * hi + j_m) * 8), vl_ = (unsigned)(r32 * 8);
    const unsigned kro16 = kl_ + rho_m * 512u, kro4 = kl_ + rho_m * 65536u, vro16 = vl_ + (2 * hi) * 512u, vro4 = vl_ + (2 * hi) * 65536u;
#define DL_LOAD(KF, VF, TT) do { const int tt_ = (TT) < NT ? (TT) : NT - 1; \
        if (MODE == 1) { const bool r16_ = tt_ < 5; const int w_ = r16_ ? ib - 4 + tt_ : 4 * ib - 4 + (tt_ - 5); const int wc_ = w_ < 0 ? 0 : w_; \
            const unsigned sb_ = r16_ ? (unsigned)((c * 32 + 4 * wc_) * 512) : (unsigned)(((c & 3) * 32 + wc_) * 512); \
            dil_load_u(kbh, vbh, sb_, r16_ ? kro16 : kro4, r16_ ? vro16 : vro4, r16_ ? vro16 + 512u : vro4 + 65536u, KF, VF); } \
        else { const DTile d_ = dil_decode<MODE>(tt_, c, ib); dil_load(d_, kq, vq, rho_m, j_m, hi, KF, VF); } } while (0)
#define DL_STEP(KF, VF, TT) do { const DTile dc = dil_decode<MODE>((TT), c, ib); if ((TT) < NT && (TT) < ntcap && dc.valid) { \
        f32x16 S = {}; \
        _Pragma("unroll") for (int s = 0; s < 4; ++s) S = __builtin_amdgcn_mfma_f32_32x32x16_bf16(KF[s], qf[s], S, 0, 0, 0); \
        const int stride = 16 * dc.is + dc.cs; const int dA = tq - 16 * dc.ibase - dc.cb - 2 * hi * stride, dB = dA - stride; \
        float z[16]; \
        if (MODE == 1 && (TT) >= 1 && (TT) <= 3) { _Pragma("unroll") for (int i = 0; i < 16; ++i) z[i] = S[i]; }        \
        else { _Pragma("unroll") for (int i = 0; i < 16; ++i) { const bool ok = (unsigned)(((i >> 3) ? dB : dA) - 16 * (i & 7)) <= (unsigned)dc.wr; z[i] = ok ? S[i] : -INFINITY; } } \
        float mx = __builtin_fmaxf(__builtin_fmaxf(__builtin_fmaxf(__builtin_fmaxf(z[0], z[1]), __builtin_fmaxf(z[2], z[3])), __builtin_fmaxf(__builtin_fmaxf(z[4], z[5]), __builtin_fmaxf(z[6], z[7]))), \
                                   __builtin_fmaxf(__builtin_fmaxf(__builtin_fmaxf(z[8], z[9]), __builtin_fmaxf(z[10], z[11])), __builtin_fmaxf(__builtin_fmaxf(z[12], z[13]), __builtin_fmaxf(z[14], z[15])))); \
        auto rr = __builtin_amdgcn_permlane32_swap(__float_as_uint(mx), __float_as_uint(mx), false, false); \
        mx = fmaxf(__uint_as_float(rr[0]), __uint_as_float(rr[1])); \
        if (__ballot(mx > mrun) != 0ull) { const float mnew = fmaxf(mrun, mx); const float alpha = __builtin_amdgcn_exp2f(mrun - mnew); mrun = mnew; l *= alpha; \
            _Pragma("unroll") for (int i = 0; i < 16; ++i) { o0[i] *= alpha; o1[i] *= alpha; } } \
        float p[16]; \
        _Pragma("unroll") for (int i = 0; i < 16; ++i) p[i] = __builtin_amdgcn_exp2f(z[i] - mrun); \
        l += (((p[0] + p[1]) + (p[2] + p[3])) + ((p[4] + p[5]) + (p[6] + p[7]))) + (((p[8] + p[9]) + (p[10] + p[11])) + ((p[12] + p[13]) + (p[14] + p[15]))); \
        const bf16x8 p0 = pack8(p), p1 = pack8(p + 8); \
        o0 = __builtin_amdgcn_mfma_f32_32x32x16_bf16(VF[0], p0, o0, 0, 0, 0); o0 = __builtin_amdgcn_mfma_f32_32x32x16_bf16(VF[1], p1, o0, 0, 0, 0); \
        o1 = __builtin_amdgcn_mfma_f32_32x32x16_bf16(VF[2], p0, o1, 0, 0, 0); o1 = __builtin_amdgcn_mfma_f32_32x32x16_bf16(VF[3], p1, o1, 0, 0, 0); } } while (0)
    DL_LOAD(kA, vA, 0); DL_LOAD(kB, vB, 1);
    for (int tt = 0; tt < NT; tt += 3) {
        DL_LOAD(kC, vC, tt + 2); DL_STEP(kA, vA, tt);
        DL_LOAD(kA, vA, tt + 3); DL_STEP(kB, vB, tt + 1);
        DL_LOAD(kB, vB, tt + 4); DL_STEP(kC, vC, tt + 2);
    }
#undef DL_LOAD
#undef DL_STEP
    auto rr = __builtin_amdgcn_permlane32_swap(__float_as_uint(l), __float_as_uint(l), false, false);
    const float lt = __uint_as_float(rr[0]) + __uint_as_float(rr[1]);
    const size_t orow = (rowbase + tq) * DM + h * HD;
    if (MODE == 0) {
        o_to_lds(scr, o0, o1, 1.0f / lt, r32, hi); lds_to_rows(scr, X1 + rowbase * DM + h * HD, t0, ts, lane);
        if (hi == 0) LSE[(rowbase + tq) * 16 + h] = mrun + __builtin_amdgcn_logf(lt);
    } else {
        rows_to_lds(scr, X1 + rowbase * DM + h * HD, t0, ts, lane);
        const float lse1 = LSE[(rowbase + tq) * 16 + h];
        const float M = fmaxf(mrun, lse1), w2 = __builtin_amdgcn_exp2f(mrun - M), w1 = __builtin_amdgcn_exp2f(lse1 - M), inv = 1.0f / (lt * w2 + w1), a2 = w2 * inv, a1 = w1 * inv;
#pragma unroll
        for (int g = 0; g < 4; ++g) {
            const u32x2 x0 = *(LAS u32x2*)(scr + r32 * SCR_PITCH + (8 * g + 4 * hi) * 2), x1 = *(LAS u32x2*)(scr + r32 * SCR_PITCH + (32 + 8 * g + 4 * hi) * 2);
            o0[4 * g] = o0[4 * g] * a2 + __uint_as_float(x0.x << 16) * a1; o0[4 * g + 1] = o0[4 * g + 1] * a2 + __uint_as_float(x0.x & 0xffff0000u) * a1;
            o0[4 * g + 2] = o0[4 * g + 2] * a2 + __uint_as_float(x0.y << 16) * a1; o0[4 * g + 3] = o0[4 * g + 3] * a2 + __uint_as_float(x0.y & 0xffff0000u) * a1;
            o1[4 * g] = o1[4 * g] * a2 + __uint_as_float(x1.x << 16) * a1; o1[4 * g + 1] = o1[4 * g + 1] * a2 + __uint_as_float(x1.x & 0xffff0000u) * a1;
            o1[4 * g + 2] = o1[4 * g + 2] * a2 + __uint_as_float(x1.y << 16) * a1; o1[4 * g + 3] = o1[4 * g + 3] * a2 + __uint_as_float(x1.y & 0xffff0000u) * a1;
        }
        o_to_lds(scr, o0, o1, 1.0f, r32, hi); lds_to_rows(scr, O + rowbase * DM + h * HD, t0, ts, lane);
    }
}


#define ATT_WAITBAR() asm volatile("s_waitcnt lgkmcnt(0)\n\ts_barrier" ::: "memory")
typedef LAS bf16x8* lds_v8;
__device__ __forceinline__ void sb_group(const bf16_t* Q, const bf16_t* Kb, const bf16_t* Vt, bf16_t* O, int bh, int g, int tid, LAS unsigned char* lds) {
    const int lane = tid & 63, wave = __builtin_amdgcn_readfirstlane(tid >> 6), r32 = lane & 31, hi = lane >> 5;
    const int b = bh >> 4, h = bh & 15, qb = 8 * g + wave, top = 8 * g + 7;
    const size_t rowbase = (size_t)b * SEQ;
    LAS unsigned char* scr = lds + SCR_OFF + wave * SCR_BYTES;
    rows_to_lds(scr, Q + rowbase * DM + h * HD, qb * 32, 1, lane);
    bf16x8 qf[4];
#pragma unroll
    for (int s = 0; s < 4; ++s) qf[s] = *(LAS bf16x8*)(scr + r32 * SCR_PITCH + (2 * s + hi) * 16);
    const bf16_t* src = ((tid < 256) ? Kb : Vt) + (size_t)bh * (128 * 2048) + (tid & 255) * 8;
    LAS unsigned char* dst = lds + tid * 16;
    LAS unsigned char* rdp = lds + lane * 16;
    volatile LAS unsigned* flags = (volatile LAS unsigned*)(lds + 32768);
#define SG_GLOAD(JT) (*(const bf16x8*)(src + (size_t)((JT) < 0 ? 0 : (JT)) * 2048))
    bf16x8 r0 = SG_GLOAD(top), r1 = SG_GLOAD(top - 1), rh = SG_GLOAD(top - 2);
    ATT_WAITBAR();
    *(lds_v8)(dst) = r0; *(lds_v8)(dst + 8192) = r1;
    f32x16 o0 = {}, o1 = {}; float P = 1.0f;
    for (int t = 0; ; ++t) {
        const int jt = top - t, slot = (t & 3) * 8192;
        const bf16x8 rn = SG_GLOAD(jt - 3);
        *(lds_v8)(dst + ((t + 2) & 3) * 8192) = rh;
        const bool mine = (jt <= qb) && (jt >= 0) && (__ballot(P != 0.0f) != 0ull);
        if (lane == 0) flags[(t & 1) * 8 + wave] = (jt >= 0 && (jt > qb || mine)) ? 1u : 0u;
        ATT_WAITBAR();
        { const u32x4 fa = *(LAS u32x4*)(lds + 32768 + (t & 1) * 32), fb = *(LAS u32x4*)(lds + 32768 + (t & 1) * 32 + 16);
          if (((fa.x | fa.y) | (fa.z | fa.w) | (fb.x | fb.y) | (fb.z | fb.w)) == 0u) break; }
        if (mine) {
            bf16x8 KF[4], VF[4];
#pragma unroll
            for (int s = 0; s < 4; ++s) { KF[s] = *(lds_v8)(rdp + slot + s * 1024); VF[s] = *(lds_v8)(rdp + slot + 4096 + s * 1024); }
            f32x16 S = {};
#pragma unroll
            for (int s = 0; s < 4; ++s) S = __builtin_amdgcn_mfma_f32_32x32x16_bf16(KF[s], qf[s], S, 0, 0, 0);
            float r[16]; const bool diag = (jt == qb);
#pragma unroll
            for (int i = 0; i < 16; ++i) { float e = __builtin_amdgcn_exp2f(S[i]); if (diag && (16 * hi + i >= r32)) e = 0.f; r[i] = __builtin_amdgcn_rcpf(1.0f + e); }
            const float t8a = ((r[8] * r[9]) * (r[10] * r[11])) * ((r[12] * r[13]) * (r[14] * r[15])), t8b = ((r[0] * r[1]) * (r[2] * r[3])) * ((r[4] * r[5]) * (r[6] * r[7])), tot = t8a * t8b;
            auto rr = __builtin_amdgcn_permlane32_swap(__float_as_uint(tot), __float_as_uint(tot), false, false);
            const float tot_lo = __uint_as_float(rr[0]), tot_hi = __uint_as_float(rr[1]);
            float A = hi ? P : P * tot_hi; float B2 = A * t8a; P = P * tot_lo * tot_hi; float w[16];
#pragma unroll
            for (int i = 7; i >= 0; --i) { const float An = A * r[8 + i]; w[8 + i] = A - An; A = An; const float Bn = B2 * r[i]; w[i] = B2 - Bn; B2 = Bn; }
            const bf16x8 p0 = pack8(w), p1 = pack8(w + 8);
            o0 = __builtin_amdgcn_mfma_f32_32x32x16_bf16(VF[0], p0, o0, 0, 0, 0); o0 = __builtin_amdgcn_mfma_f32_32x32x16_bf16(VF[1], p1, o0, 0, 0, 0);
            o1 = __builtin_amdgcn_mfma_f32_32x32x16_bf16(VF[2], p0, o1, 0, 0, 0); o1 = __builtin_amdgcn_mfma_f32_32x32x16_bf16(VF[3], p1, o1, 0, 0, 0);
        }
        rh = rn;
    }
#undef SG_GLOAD
    o_to_lds(scr, o0, o1, 1.0f, r32, hi);
    lds_to_rows(scr, O + rowbase * DM + h * HD, qb * 32, 1, lane);
}
constexpr int SBW_TILES = 14, SBW_SCR = SBW_TILES * 8192;
__device__ __forceinline__ void sb_step(const bf16x8* KF, const bf16x8* VF, const bf16x8* qf, f32x16& o0, f32x16& o1, float& P, bool diag, int r32, int hi) {
    f32x16 S = {};
#pragma unroll
    for (int s = 0; s < 4; ++s) S = __builtin_amdgcn_mfma_f32_32x32x16_bf16(KF[s], qf[s], S, 0, 0, 0);
    float r[16];
#pragma unroll
    for (int i = 0; i < 16; ++i) { float e = __builtin_amdgcn_exp2f(S[i]); if (diag && (16 * hi + i >= r32)) e = 0.f; r[i] = __builtin_amdgcn_rcpf(1.0f + e); }
    const float t8a = ((r[8] * r[9]) * (r[10] * r[11])) * ((r[12] * r[13]) * (r[14] * r[15])), t8b = ((r[0] * r[1]) * (r[2] * r[3])) * ((r[4] * r[5]) * (r[6] * r[7])), tot = t8a * t8b;
    auto rr = __builtin_amdgcn_permlane32_swap(__float_as_uint(tot), __float_as_uint(tot), false, false);
    const float tot_lo = __uint_as_float(rr[0]), tot_hi = __uint_as_float(rr[1]);
    float A = hi ? P : P * tot_hi; float B2 = A * t8a; P = P * tot_lo * tot_hi; float w[16];
#pragma unroll
    for (int i = 7; i >= 0; --i) { const float An = A * r[8 + i]; w[8 + i] = A - An; A = An; const float Bn = B2 * r[i]; w[i] = B2 - Bn; B2 = Bn; }
    const bf16x8 p0 = pack8(w), p1 = pack8(w + 8);
    o0 = __builtin_amdgcn_mfma_f32_32x32x16_bf16(VF[0], p0, o0, 0, 0, 0); o0 = __builtin_amdgcn_mfma_f32_32x32x16_bf16(VF[1], p1, o0, 0, 0, 0);
    o1 = __builtin_amdgcn_mfma_f32_32x32x16_bf16(VF[2], p0, o1, 0, 0, 0); o1 = __builtin_amdgcn_mfma_f32_32x32x16_bf16(VF[3], p1, o1, 0, 0, 0);
}
__device__ __forceinline__ void sb_groups(const bf16_t* Q, const bf16_t* Kb, const bf16_t* Vt, bf16_t* O, int bid, int G, int tid, LAS unsigned char* lds) {
    const int lane = tid & 63, wave = __builtin_amdgcn_readfirstlane(tid >> 6), r32 = lane & 31, hi = lane >> 5;
    LAS unsigned char* scr = lds + SBW_SCR + wave * SCR_BYTES;
    LAS unsigned char* wdst = lds + tid * 16;
    LAS unsigned char* rdp = lds + lane * 16;
    bf16x8 W[SBW_TILES]; u32x4 QR[4];
#define SBW_ITEM(U, BH, GR) const int BH = (U) & 255, GR = (((U) >> 8) & 1) ? 15 - ((U) >> 9) : ((U) >> 9)
#define SBW_PREFETCH(U) do { SBW_ITEM(U, bh_, g_); const int top_ = 8 * g_ + 7; \
        const bf16_t* src_ = ((tid < 256) ? Kb : Vt) + (size_t)bh_ * (128 * 2048) + (tid & 255) * 8; \
        _Pragma("unroll") for (int k = 0; k < SBW_TILES; ++k) { const int jt_ = top_ - k; W[k] = *(const bf16x8*)(src_ + (size_t)(jt_ < 0 ? 0 : jt_) * 2048); } \
        const bf16_t* qb_ = Q + ((size_t)(bh_ >> 4) * SEQ) * DM + (bh_ & 15) * HD; \
        _Pragma("unroll") for (int k = 0; k < 4; ++k) QR[k] = __builtin_nontemporal_load((const u32x4*)(qb_ + (size_t)((8 * g_ + wave) * 32 + 8 * k + (lane >> 3)) * DM + (lane & 7) * 8)); } while (0)
    if (bid < 4096) SBW_PREFETCH(bid);
    for (int unit = bid; unit < 4096; unit += G) {
        SBW_ITEM(unit, bh, g);
        const int b = bh >> 4, h = bh & 15, qb = 8 * g + wave, top = 8 * g + 7, wlo = top - (SBW_TILES - 1);
        const size_t rowbase = (size_t)b * SEQ;
        ATT_WAITBAR();
#pragma unroll
        for (int k = 0; k < SBW_TILES; ++k) *(lds_v8)(wdst + k * 8192) = W[k];
#pragma unroll
        for (int k = 0; k < 4; ++k) *(LAS u32x4*)(scr + (8 * k + (lane >> 3)) * SCR_PITCH + (lane & 7) * 16) = QR[k];
        ATT_WAITBAR();
        if (unit + G < 4096) SBW_PREFETCH(unit + G);
        bf16x8 qf[4];
#pragma unroll
        for (int s = 0; s < 4; ++s) qf[s] = *(LAS bf16x8*)(scr + r32 * SCR_PITCH + (2 * s + hi) * 16);
        f32x16 o0 = {}, o1 = {}; float P = 1.0f; int jt = qb;
        for (; jt >= 0 && jt >= wlo; --jt) {
            const int slot = (top - jt) * 8192; bf16x8 KF[4], VF[4];
#pragma unroll
            for (int s = 0; s < 4; ++s) { KF[s] = *(lds_v8)(rdp + slot + s * 1024); VF[s] = *(lds_v8)(rdp + slot + 4096 + s * 1024); }
            sb_step(KF, VF, qf, o0, o1, P, jt == qb, r32, hi);
            if (__ballot(P != 0.0f) == 0ull) { jt = -1; break; }
        }
        for (; jt >= 0; --jt) {
            const bf16_t* kt = Kb + (size_t)bh * (128 * 2048) + (size_t)jt * 2048 + lane * 8; const bf16_t* vt = Vt + (size_t)bh * (128 * 2048) + (size_t)jt * 2048 + lane * 8; bf16x8 KF[4], VF[4];
#pragma unroll
            for (int s = 0; s < 4; ++s) { KF[s] = *(const bf16x8*)(kt + 512 * s); VF[s] = *(const bf16x8*)(vt + 512 * s); }
            sb_step(KF, VF, qf, o0, o1, P, false, r32, hi);
            if (__ballot(P != 0.0f) == 0ull) break;
        }
        o_to_lds(scr, o0, o1, 1.0f, r32, hi);
        lds_to_rows(scr, O + rowbase * DM + h * HD, qb * 32, 1, lane);
    }
#undef SBW_ITEM
#undef SBW_PREFETCH
}
__device__ __forceinline__ void dil_group0(const bf16_t* Q, const bf16_t* Kb, const bf16_t* Vt, bf16_t* X1, float* LSE, int bh, int g, int tid, LAS unsigned char* lds) {
    const int lane = tid & 63, wave = __builtin_amdgcn_readfirstlane(tid >> 6), r32 = lane & 31, hi = lane >> 5;
    const int b = bh >> 4, h = bh & 15, blk = 8 * g + wave, tq = 32 * blk + r32, vlo = wave >> 2;
    const size_t rowbase = (size_t)b * SEQ;
    LAS unsigned char* scr = lds + SCR_OFF + wave * SCR_BYTES;
    rows_to_lds(scr, Q + rowbase * DM + h * HD, 32 * blk, 1, lane);
    bf16x8 qf[4];
#pragma unroll
    for (int s = 0; s < 4; ++s) qf[s] = *(LAS bf16x8*)(scr + r32 * SCR_PITCH + (2 * s + hi) * 16);
    const int u_m = (r32 >> 4) & 1, hi_m = (r32 >> 2) & 1, j_m = (r32 & 3) + 4 * ((r32 >> 3) & 1), rho_m = 2 * hi_m + u_m;
    const int part = tid >> 6, rho_s = part & 3;
    const bf16_t* src = ((part < 4) ? Kb : Vt) + (size_t)bh * (16 * 32 * 512) + (size_t)rho_s * (32 * 512) + (tid & 63) * 8;
    LAS unsigned char* dst = lds + part * 1024 + (tid & 63) * 16;
    LAS unsigned char* krd = lds + rho_m * 1024 + (hi * 8 + j_m) * 16;
    LAS unsigned char* vrd = lds + 4096 + (2 * hi) * 1024 + r32 * 16;
#define DG_GLOAD(T) (*(const bf16x8*)(src + (size_t)((((T) < 12 ? (T) : 11) & 3) * 4 * 32 + (2 * g - 1 + (((T) < 12 ? (T) : 11) >> 2) < 0 ? 0 : 2 * g - 1 + (((T) < 12 ? (T) : 11) >> 2))) * 512))
    bf16x8 r0 = DG_GLOAD(0), r1 = DG_GLOAD(1), rh = DG_GLOAD(2);
    ATT_WAITBAR();
    *(lds_v8)(dst) = r0; *(lds_v8)(dst + 8192) = r1;
    f32x16 o0 = {}, o1 = {}; float mrun = -1e30f, l = 0.f;
    for (int t = 0; t < 12; ++t) {
        const int v = t >> 2, a = t & 3, w = 2 * g - 1 + v, slot = (t & 3) * 8192;
        const bf16x8 rn = DG_GLOAD(t + 3);
        *(lds_v8)(dst + ((t + 2) & 3) * 8192) = rh;
        ATT_WAITBAR();
        if (w >= 0 && (v == vlo || v == vlo + 1)) {
            bf16x8 KF[4], VF[4];
#pragma unroll
            for (int s = 0; s < 4; ++s) KF[s] = *(lds_v8)(krd + slot + s * 256);
            VF[0] = *(lds_v8)(vrd + slot); VF[1] = *(lds_v8)(vrd + slot + 1024); VF[2] = *(lds_v8)(vrd + slot + 512); VF[3] = *(lds_v8)(vrd + slot + 1024 + 512);
            f32x16 S = {};
#pragma unroll
            for (int s = 0; s < 4; ++s) S = __builtin_amdgcn_mfma_f32_32x32x16_bf16(KF[s], qf[s], S, 0, 0, 0);
            const int dA = tq - 128 * w - 4 * a - 2 * hi, dB = dA - 1;
            float z[16];
#pragma unroll
            for (int i = 0; i < 16; ++i) { const bool ok = (unsigned)(((i >> 3) ? dB : dA) - 16 * (i & 7)) <= 128u; z[i] = ok ? S[i] : -INFINITY; }
            float mx = __builtin_fmaxf(__builtin_fmaxf(__builtin_fmaxf(__builtin_fmaxf(z[0], z[1]), __builtin_fmaxf(z[2], z[3])), __builtin_fmaxf(__builtin_fmaxf(z[4], z[5]), __builtin_fmaxf(z[6], z[7]))),
                                       __builtin_fmaxf(__builtin_fmaxf(__builtin_fmaxf(z[8], z[9]), __builtin_fmaxf(z[10], z[11])), __builtin_fmaxf(__builtin_fmaxf(z[12], z[13]), __builtin_fmaxf(z[14], z[15]))));
            auto rr = __builtin_amdgcn_permlane32_swap(__float_as_uint(mx), __float_as_uint(mx), false, false);
            mx = fmaxf(__uint_as_float(rr[0]), __uint_as_float(rr[1]));
            if (__ballot(mx > mrun) != 0ull) { const float mnew = fmaxf(mrun, mx); const float alpha = __builtin_amdgcn_exp2f(mrun - mnew); mrun = mnew; l *= alpha;
#pragma unroll
                for (int i = 0; i < 16; ++i) { o0[i] *= alpha; o1[i] *= alpha; } }
            float p[16];
#pragma unroll
            for (int i = 0; i < 16; ++i) p[i] = __builtin_amdgcn_exp2f(z[i] - mrun);
            l += (((p[0] + p[1]) + (p[2] + p[3])) + ((p[4] + p[5]) + (p[6] + p[7]))) + (((p[8] + p[9]) + (p[10] + p[11])) + ((p[12] + p[13]) + (p[14] + p[15])));
            const bf16x8 p0 = pack8(p), p1 = pack8(p + 8);
            o0 = __builtin_amdgcn_mfma_f32_32x32x16_bf16(VF[0], p0, o0, 0, 0, 0); o0 = __builtin_amdgcn_mfma_f32_32x32x16_bf16(VF[1], p1, o0, 0, 0, 0);
            o1 = __builtin_amdgcn_mfma_f32_32x32x16_bf16(VF[2], p0, o1, 0, 0, 0); o1 = __builtin_amdgcn_mfma_f32_32x32x16_bf16(VF[3], p1, o1, 0, 0, 0);
        }
        rh = rn;
    }
#undef DG_GLOAD
    auto rr = __builtin_amdgcn_permlane32_swap(__float_as_uint(l), __float_as_uint(l), false, false);
    const float lt = __uint_as_float(rr[0]) + __uint_as_float(rr[1]);
    o_to_lds(scr, o0, o1, 1.0f / lt, r32, hi);
    lds_to_rows(scr, X1 + rowbase * DM + h * HD, 32 * blk, 1, lane);
    if (hi == 0) LSE[(rowbase + tq) * 16 + h] = mrun + __builtin_amdgcn_logf(lt);
}

__device__ __forceinline__ void dil_groups0(const bf16_t* Q, const bf16_t* Kb, const bf16_t* Vt, bf16_t* X1, float* LSE, bool xo, int xcd, int myr, int bid, int G, int tid, LAS unsigned char* lds) {
    const int lane = tid & 63, wave = __builtin_amdgcn_readfirstlane(tid >> 6), r32 = lane & 31, hi = lane >> 5, vlo = wave >> 2;
    LAS unsigned char* scr = lds + SBW_SCR + wave * SCR_BYTES;
    const int part = tid >> 6, rho_s = part & 3;
    LAS unsigned char* wdst = lds + part * 1024 + (tid & 63) * 16;
    const int u_m = (r32 >> 4) & 1, hi_m = (r32 >> 2) & 1, j_m = (r32 & 3) + 4 * ((r32 >> 3) & 1), rho_m = 2 * hi_m + u_m;
    LAS unsigned char* krd = lds + rho_m * 1024 + (hi * 8 + j_m) * 16;
    LAS unsigned char* vrd = lds + 4096 + (2 * hi) * 1024 + r32 * 16;
    const int nit = xo ? 16 : (4096 - bid + G - 1) / G;
    bf16x8 W[12]; u32x4 QR[4];
#define DG_ITEM(I, BH, GR) const int u__##BH = xo ? myr + 32 * (I) : bid + G * (I); const int BH = xo ? xcd * 32 + (u__##BH >> 4) : (u__##BH >> 4), GR = u__##BH & 15
#define DG_PREFETCH(I) do { DG_ITEM(I, bh_, g_); \
        const bf16_t* src_ = ((part < 4) ? Kb : Vt) + (size_t)bh_ * (16 * 32 * 512) + (size_t)rho_s * (32 * 512) + (tid & 63) * 8; \
        _Pragma("unroll") for (int t = 0; t < 12; ++t) { const int w_ = 2 * g_ - 1 + (t >> 2); W[t] = *(const bf16x8*)(src_ + (size_t)((t & 3) * 4 * 32 + (w_ < 0 ? 0 : w_)) * 512); } \
        const bf16_t* qb_ = Q + ((size_t)(bh_ >> 4) * SEQ) * DM + (bh_ & 15) * HD; \
        _Pragma("unroll") for (int k = 0; k < 4; ++k) QR[k] = __builtin_nontemporal_load((const u32x4*)(qb_ + (size_t)((8 * g_ + wave) * 32 + 8 * k + (lane >> 3)) * DM + (lane & 7) * 8)); } while (0)
    if (nit > 0) DG_PREFETCH(0);
    for (int it = 0; it < nit; ++it) {
        DG_ITEM(it, bh, g);
        const int b = bh >> 4, h = bh & 15, blk = 8 * g + wave, tq = 32 * blk + r32;
        const size_t rowbase = (size_t)b * SEQ;
        ATT_WAITBAR();
#pragma unroll
        for (int t = 0; t < 12; ++t) *(lds_v8)(wdst + t * 8192) = W[t];
#pragma unroll
        for (int k = 0; k < 4; ++k) *(LAS u32x4*)(scr + (8 * k + (lane >> 3)) * SCR_PITCH + (lane & 7) * 16) = QR[k];
        ATT_WAITBAR();
        if (it + 1 < nit) DG_PREFETCH(it + 1);
        bf16x8 qf[4];
#pragma unroll
        for (int s = 0; s < 4; ++s) qf[s] = *(LAS bf16x8*)(scr + r32 * SCR_PITCH + (2 * s + hi) * 16);
        f32x16 o0 = {}, o1 = {}; float mrun = -1e30f, l = 0.f;
        for (int t = 4 * vlo; t < 4 * vlo + 8; ++t) {
            const int v = t >> 2, a = t & 3, w = 2 * g - 1 + v, slot = t * 8192;
            if (w < 0) continue;
            bf16x8 KF[4], VF[4];
#pragma unroll
            for (int s = 0; s < 4; ++s) KF[s] = *(lds_v8)(krd + slot + s * 256);
            VF[0] = *(lds_v8)(vrd + slot); VF[1] = *(lds_v8)(vrd + slot + 1024); VF[2] = *(lds_v8)(vrd + slot + 512); VF[3] = *(lds_v8)(vrd + slot + 1024 + 512);
            f32x16 S = {};
#pragma unroll
            for (int s = 0; s < 4; ++s) S = __builtin_amdgcn_mfma_f32_32x32x16_bf16(KF[s], qf[s], S, 0, 0, 0);
            const int dA = tq - 128 * w - 4 * a - 2 * hi, dB = dA - 1;
            float z[16];
#pragma unroll
            for (int i = 0; i < 16; ++i) { const bool ok = (unsigned)(((i >> 3) ? dB : dA) - 16 * (i & 7)) <= 128u; z[i] = ok ? S[i] : -INFINITY; }
            float mx = __builtin_fmaxf(__builtin_fmaxf(__builtin_fmaxf(__builtin_fmaxf(z[0], z[1]), __builtin_fmaxf(z[2], z[3])), __builtin_fmaxf(__builtin_fmaxf(z[4], z[5]), __builtin_fmaxf(z[6], z[7]))),
                                       __builtin_fmaxf(__builtin_fmaxf(__builtin_fmaxf(z[8], z[9]), __builtin_fmaxf(z[10], z[11])), __builtin_fmaxf(__builtin_fmaxf(z[12], z[13]), __builtin_fmaxf(z[14], z[15]))));
            auto rr = __builtin_amdgcn_permlane32_swap(__float_as_uint(mx), __float_as_uint(mx), false, false);
            mx = fmaxf(__uint_as_float(rr[0]), __uint_as_float(rr[1]));
            if (__ballot(mx > mrun) != 0ull) { const float mnew = fmaxf(mrun, mx); const float alpha = __builtin_amdgcn_exp2f(mrun - mnew); mrun = mnew; l *= alpha;
#pragma unroll
                for (int i = 0; i < 16; ++i) { o0[i] *= alpha; o1[i] *= alpha; } }
            float p[16];
#pragma unroll
            for (int i = 0; i < 16; ++i) p[i] = __builtin_amdgcn_exp2f(z[i] - mrun);
            l += (((p[0] + p[1]) + (p[2] + p[3])) + ((p[4] + p[5]) + (p[6] + p[7]))) + (((p[8] + p[9]) + (p[10] + p[11])) + ((p[12] + p[13]) + (p[14] + p[15])));
            const bf16x8 p0 = pack8(p), p1 = pack8(p + 8);
            o0 = __builtin_amdgcn_mfma_f32_32x32x16_bf16(VF[0], p0, o0, 0, 0, 0); o0 = __builtin_amdgcn_mfma_f32_32x32x16_bf16(VF[1], p1, o0, 0, 0, 0);
            o1 = __builtin_amdgcn_mfma_f32_32x32x16_bf16(VF[2], p0, o1, 0, 0, 0); o1 = __builtin_amdgcn_mfma_f32_32x32x16_bf16(VF[3], p1, o1, 0, 0, 0);
        }
        auto rr = __builtin_amdgcn_permlane32_swap(__float_as_uint(l), __float_as_uint(l), false, false);
        const float lt = __uint_as_float(rr[0]) + __uint_as_float(rr[1]);
        o_to_lds(scr, o0, o1, 1.0f / lt, r32, hi);
        lds_to_rows(scr, X1 + rowbase * DM + h * HD, 32 * blk, 1, lane);
        if (hi == 0) LSE[(rowbase + tq) * 16 + h] = mrun + __builtin_amdgcn_logf(lt);
    }
#undef DG_ITEM
#undef DG_PREFETCH
}

#define GAS __attribute__((address_space(1)))
__device__ __forceinline__ unsigned xb_ld(unsigned* p)              { return __hip_atomic_load(p, __ATOMIC_RELAXED, __HIP_MEMORY_SCOPE_AGENT); }
__device__ __forceinline__ unsigned xb_add(unsigned* p, unsigned v) { return __hip_atomic_fetch_add(p, v, __ATOMIC_RELAXED, __HIP_MEMORY_SCOPE_AGENT); }
#define XB_TMO      128
#define XB_XCNT(j)  (256  + 64 * (j))
#define XB_XSUB(j)  (1280 + 64 * (j))
#define XB_XGEN(j)  (2304 + 64 * (j))
#define XB_TOP      3328
#define XB_TOPGEN   3392
#define XCD_BAR_WORDS 3456
#define XB_SPIN_CAP (1u << 18)

__device__ __forceinline__ unsigned xb_xcc_id() { return (unsigned)__builtin_amdgcn_s_getreg((3 << 11) | 20) & 0xFu; }
#define XB_SPIN(cond, bar) do { unsigned _sp = 0; while (cond) { __builtin_amdgcn_s_sleep(1); \
    if ((++_sp & 255u) == 0u) { if (xb_ld(&(bar)[XB_TMO])) break; if (_sp > XB_SPIN_CAP) { atomicAdd(&(bar)[XB_TMO], 1u); break; } } } } while (0)

struct XcdBarrier {
    unsigned* bar; unsigned x;
    volatile LAS unsigned* st;
};

__device__ __forceinline__ XcdBarrier xcd_barrier_post(unsigned* bar, volatile LAS unsigned* st) {
    XcdBarrier b; b.bar = bar; b.x = xb_xcc_id(); b.st = st;
    if (threadIdx.x == 0) st[2] = xb_add(&bar[XB_XCNT(b.x)], 1u);
    return b;
}
__device__ __forceinline__ void xcd_barrier_complete(unsigned* bar, unsigned x, unsigned& nloc, unsigned& nx) {
    const unsigned G = gridDim.x * gridDim.y * gridDim.z;
    unsigned sum, cnt, mine, sp = 0u;
    for (;;) {
        sum = 0u; cnt = 0u; mine = 0u;
#pragma unroll
        for (unsigned j = 0; j < 16; ++j) { const unsigned c = xb_ld(&bar[XB_XCNT(j)]); sum += c; cnt += (c > 0u) ? 1u : 0u; mine = (j == x) ? c : mine; }
        if (sum == G) break;
        __builtin_amdgcn_s_sleep(1);
        if ((++sp & 255u) == 0u) { if (xb_ld(&bar[XB_TMO])) break; if (sp > XB_SPIN_CAP) { atomicAdd(&bar[XB_TMO], 1u); break; } }
    }
    nloc = mine > 0u ? mine : 1u; nx = cnt > 0u ? cnt : 1u;
}

__device__ __forceinline__ void xcd_barrier(const XcdBarrier& b) {
    asm volatile("s_waitcnt vmcnt(0)" ::: "memory");
    __syncthreads();
    if (threadIdx.x == 0) {
        unsigned* bar = b.bar;
        __builtin_amdgcn_s_waitcnt(0);
        unsigned nloc = b.st[0], nx = b.st[1];
        if (nloc == 0u) { xcd_barrier_complete(bar, b.x, nloc, nx); b.st[0] = nloc; b.st[1] = nx; }
        const unsigned old = xb_add(&bar[XB_XSUB(b.x)], 1u);
        const unsigned gen = old / nloc;
        if (old + 1u == (gen + 1u) * nloc) {
            __builtin_amdgcn_fence(__ATOMIC_RELEASE, "agent");
            asm volatile("s_waitcnt vmcnt(0)" ::: "memory");
            const unsigned og = xb_add(&bar[XB_TOP], 1u);
            const unsigned tg = og / nx;
            if (og + 1u == (tg + 1u) * nx) xb_add(&bar[XB_TOPGEN], 1u);
            else XB_SPIN(xb_ld(&bar[XB_TOPGEN]) == tg, bar);
            __builtin_amdgcn_fence(__ATOMIC_ACQUIRE, "agent");
            xb_add(&bar[XB_XGEN(b.x)], 1u);
            asm volatile("s_waitcnt vmcnt(0)" ::: "memory");
        } else {
            XB_SPIN(xb_ld(&bar[XB_XGEN(b.x)]) == gen, bar);
            __builtin_amdgcn_fence(__ATOMIC_ACQUIRE, "agent");
            asm volatile("s_waitcnt vmcnt(0)" ::: "memory");
        }
    }
    __syncthreads();
}

__global__ void __launch_bounds__(512) yoco_fwd(Args a) {
    extern __shared__ __attribute__((aligned(16))) unsigned char lds_raw[];
    LAS unsigned char* lds = (LAS unsigned char*)lds_raw;
    cg::grid_group grid = cg::this_grid();
    if (threadIdx.x < 4) ((volatile LAS unsigned*)(lds + BARW_OFF))[threadIdx.x] = 0u;
    __syncthreads();
    if (blockIdx.x == 0) { unsigned* bz = (unsigned*)(a.ws + WS_BAR); for (int i = threadIdx.x; i < (int)(BAR_BYTES / 4); i += 512) bz[i] = 0u; }
    XcdBarrier xbar; xbar.bar = (unsigned*)(a.ws + WS_BAR); xbar.x = 0; xbar.st = (volatile LAS unsigned*)(lds + BARW_OFF);
    for (int ph = a.ph_lo; ph < a.ph_hi; ++ph) {
        const int L_ = (ph - 1) / 5, sub_ = (ph - 1) % 5; const bool mid = ph > 0 && ph < NPHASE - 1;
        int nrep = 1;
        if ((PROBE == 1 || PROBE == 8) && mid && sub_ == 1 && L_ < 2) nrep = 2;
        if (PROBE == 3 && mid && sub_ == 3) nrep = 2;
        if (PROBE == 4 && mid && sub_ == 0) nrep = 2;
        if (PROBE == 5 && ph == 3) nrep = 2;
        if ((PROBE == 13 || PROBE == 16) && ph == 1) nrep = 2;
        if (PROBE == 14 && ph == 11) nrep = 2;
        if (PROBE == 15 && ph == 16) nrep = 2;
        if (PROBE == 6 && ph == 0) nrep = 2;
        for (int rep = 0; rep < nrep; ++rep) {
        int tid = threadIdx.x; asm volatile("" : "+v"(tid));
        int bid = blockIdx.x, G = gridDim.x; asm volatile("" : "+s"(bid), "+s"(G));
        const int lane = tid & 63, wave = __builtin_amdgcn_readfirstlane(tid >> 6), gw = bid * 8 + wave, ngw = G * 8;
        ArgsP ap = (ArgsP)__builtin_amdgcn_kernarg_segment_ptr(); asm volatile("" : "+s"(ap));
        unsigned char* ws = ap->ws;
        float* ssqA = (float*)(ws + WS_SSQ); float* ssqB = ssqA; const float* rope = (const float*)(ws + WS_ROPE);
        bf16_t* hb = (bf16_t*)(ws + WS_HB); bf16_t* qo = (bf16_t*)(ws + WS_QO); bf16_t* kb = (bf16_t*)(ws + WS_K); bf16_t* vt = (bf16_t*)(ws + WS_VT); bf16_t* act = (bf16_t*)(ws + WS_ACT);
        bf16_t* odst = (rep + 1 < nrep) ? act : qo;
        if (PROBE == 7 && rep == 0 && ph > 0) grid.sync();
        if (ph == 0) prologue(ap, lds, gw, ngw, wave, lane);
        else if (ph == NPHASE - 1) final_norm(ap, gw, ngw, lane);
        else {
            const int L = (ph - 1) / 5, sub = (ph - 1) % 5;
            if (sub == 0) {
                const bf16_t* W = (L < 2) ? (const bf16_t*)(ws + WS_WQKV_A + L * SZ_WQKV) : (L == 2 ? (const bf16_t*)(ws + WS_WB2) : (const bf16_t*)(ws + WS_WB3));
                const int N = (L == 3) ? 1024 : 3072;
                pg8::Gemm g{hb, W, MTOK, N, DM}; pg8::StaticOrder S; S.init(MTOK, N, G, bid);
                if (L < 2) { pg8::EpiQKV<0> E{qo, kb, vt, ssqB, rope}; pg8::gemm_phase<pg8::EpiQKV<0>, pg8::StaticOrder, true, true>(lds, g, S, E); }
                else { pg8::EpiQKV<1> E{qo, kb, vt, ssqB, rope}; pg8::gemm_phase<pg8::EpiQKV<1>, pg8::StaticOrder, true, true>(lds, g, S, E); }
            } else if (sub == 1) {
                if (L < 2) {
                    sb_groups(qo, kb, vt, odst, bid, G, tid, lds);
                } else {
                    bf16_t* x1 = act; float* lse = (float*)(ws + WS_ACT + 128 * MiB);
                    bool xo = (G == 256); { unsigned* bw = (unsigned*)(ws + WS_BAR);
#pragma unroll
                        for (int j = 0; j < 16; ++j) xo = xo && (xb_ld(&bw[XB_XCNT(j)]) == (j < 8 ? 32u : 0u)); }
                    const int myx = (int)xb_xcc_id(), myr = (int)((volatile LAS unsigned*)(lds + BARW_OFF))[2];
                    const int wpx = xo ? 256 : ngw, vw = xo ? myr * 8 + wave : gw, xcd = xo ? myx : 0, nun = xo ? 4096 : 32768;
                    dil_groups0(qo, kb, vt, x1, lse, xo, xcd, myr, bid, G, tid, lds);
                    if (PROBE == 9 || PROBE == 10) { int t3 = threadIdx.x; asm volatile("" : "+v"(t3)); const int lane3 = t3 & 63;
                        for (int u = vw; u < nun; u += wpx) { const int bh = xcd * 32 + (u >> 7), rem = u & 127; dil_unit<0>(qo, kb, vt, qo, x1 + 136 * MiB / 2, lse + 66 * MiB, bh, 0, rem, lane3, lds + SCR_OFF + wave * SCR_BYTES, PROBE == 9 ? 64 : 2); } }
                    if (PROBE == 12) { int t3 = threadIdx.x; asm volatile("" : "+v"(t3));
                        if (xo) { for (int u = myr; u < 512; u += 32) dil_group0(qo, kb, vt, x1 + 136 * MiB / 2, lse + 66 * MiB, xcd * 32 + (u >> 4), u & 15, t3, lds); }
                        else { for (int u = bid; u < 4096; u += G) dil_group0(qo, kb, vt, x1 + 136 * MiB / 2, lse + 66 * MiB, u >> 4, u & 15, t3, lds); } }
                    xcd_barrier(xbar);
                    if (PROBE == 11) { int t4 = threadIdx.x; asm volatile("" : "+v"(t4)); const int lane4 = t4 & 63;
                        for (int u = vw; u < nun; u += wpx) { const int bh = xcd * 32 + (u >> 7), rem = u & 127; dil_unit<1>(qo, kb, vt, x1 + 136 * MiB / 2, x1, lse, bh, rem & 15, rem >> 4, lane4, lds + SCR_OFF + wave * SCR_BYTES); } }
                    { int t2 = threadIdx.x; asm volatile("" : "+v"(t2)); const int lane2 = t2 & 63;
                    for (int u = vw; u < nun; u += wpx) { const int bh = xcd * 32 + (u >> 7), rem = u & 127; dil_unit<1>(qo, kb, vt, qo, x1, lse, bh, rem & 15, rem >> 4, lane2, lds + SCR_OFF + wave * SCR_BYTES); } }
                }
            } else if (sub == 2) {
                const bf16_t* W = (L < 2) ? (const bf16_t*)(ws + WS_WO_A + L * SZ_WSQ) : (const bf16_t*)(ws + WS_WO_B + (L - 2) * SZ_WSQ);
                pg8::Gemm g{qo, W, MTOK, DM, DM}; pg8::StaticOrder S; S.init(MTOK, DM, G, bid);
                pg8::EpiRes E{hb, ssqA};
                pg8::gemm_phase<pg8::EpiRes, pg8::StaticOrder, true, true>(lds, g, S, E);
            } else if (sub == 3) {
                pg8::Gemm g{hb, (const bf16_t*)(ws + WS_WGU + L * SZ_WGU), MTOK, 2 * DFF, DM}; pg8::StaticOrder S; S.init(MTOK, 2 * DFF, G, bid);
                pg8::EpiSwiGLU E{act, ssqA};
                pg8::gemm_phase<pg8::EpiSwiGLU, pg8::StaticOrder, true, true>(lds, g, S, E);
            } else {
                pg8::Gemm g{act, (const bf16_t*)(ws + WS_WDN + L * SZ_WDN), MTOK, DM, DFF}; pg8::StaticOrder S; S.init(MTOK, DM, G, bid);
                pg8::EpiRes E{hb, ssqB};
                pg8::gemm_phase<pg8::EpiRes, pg8::StaticOrder, true, true>(lds, g, S, E);
            }
        }
        }
        if (ph + 1 < a.ph_hi) { if (ph == a.ph_lo) { grid.sync(); xbar = xcd_barrier_post((unsigned*)(a.ws + WS_BAR), (volatile LAS unsigned*)(lds + BARW_OFF)); } else xcd_barrier(xbar); }
    }
}

#ifndef N_LAUNCHES
#define N_LAUNCHES 1
#endif
extern "C" void kernel_launch(void* const* d_in, const int* in_sizes, int n_in, void* d_out, int out_size, void* d_ws, size_t ws_size, hipStream_t stream) {
    static int grid = 0;
    if (grid == 0) {
        if (n_in != 13 || in_sizes[0] != MTOK * DM || out_size != MTOK * DM || ws_size < WS_END) { fprintf(stderr, "kernel_launch: unexpected shapes / workspace (n_in %d, ws %zu)\n", n_in, ws_size); grid = -1; return; }
        int dev = 0, cus = 0, per_cu = 0;
        (void)hipGetDevice(&dev); (void)hipDeviceGetAttribute(&cus, hipDeviceAttributeMultiprocessorCount, dev);
        if (hipFuncSetAttribute((const void*)yoco_fwd, hipFuncAttributeMaxDynamicSharedMemorySize, LDS_BYTES) != hipSuccess) { fprintf(stderr, "kernel_launch: hipFuncSetAttribute failed\n"); grid = -1; return; }
        if (hipOccupancyMaxActiveBlocksPerMultiprocessor(&per_cu, (const void*)yoco_fwd, 512, LDS_BYTES) != hipSuccess || per_cu < 1) per_cu = 1;
        (void)hipGetLastError();
        grid = cus * per_cu;
        if (grid > 256) grid = 256;
    }
    if (grid < 0) return;
    Args a{};
    for (int i = 0; i < 13; ++i) a.in[i] = (const float*)d_in[i];
    a.out = (float*)d_out; a.ws = (unsigned char*)d_ws;
    if (N_LAUNCHES == 1) {
        a.ph_lo = 0; a.ph_hi = NPHASE;
        void* kargs[] = {&a};
        hipError_t e = hipLaunchCooperativeKernel((const void*)yoco_fwd, dim3(grid), dim3(512), kargs, LDS_BYTES, stream);
        if (e != hipSuccess) fprintf(stderr, "cooperative launch failed: %s (grid %d)\n", hipGetErrorString(e), grid);
    } else {
        for (int ph = 0; ph < NPHASE; ++ph) { a.ph_lo = ph; a.ph_hi = ph + 1; hipLaunchKernelGGL(yoco_fwd, dim3(grid), dim3(512), LDS_BYTES, stream, a); }
    }
}
```

```cpp
#include <hip/hip_runtime.h>
#include <hip/hip_cooperative_groups.h>
#include <cstdio>
#include <cstdint>
namespace cg = cooperative_groups;
namespace pg8 {
#define PG8_LAS __attribute__((address_space(3)))
typedef unsigned short bf16_t;
typedef short bf16x8 __attribute__((ext_vector_type(8)));
typedef float f32x4 __attribute__((ext_vector_type(4)));
typedef unsigned u32x4 __attribute__((ext_vector_type(4)));
constexpr int BM = 256, BK = 64, HALF = 128, HTB = HALF * BK * 2  , STAGE_BYTES = 8 * HTB, NXCD = 8, WGM = 8;

__host__ __device__ __forceinline__ int lds_byte(int r, int c) { const int st = (r >> 4) * 2 + (c >> 5), rr = r & 15, cc = c & 31, ob = rr * 64 + cc * 2; return st * 1024 + (ob ^ (((ob >> 9) & 1) << 5)); }
__host__ __device__ __forceinline__ void stage_rc(int b, int& R, int& C) { const int st = b / 1024, sb = b % 1024, swz = sb ^ (((sb >> 9) & 1) << 5); R = (st >> 1) * 16 + swz / 64; C = (st & 1) * 32 + (swz % 64) / 2; }
__host__ __device__ __forceinline__ int perm32(int rho) { const int n = rho >> 4, i = rho & 15; return 8 * (i >> 2) + 4 * n + (i & 3); }

struct Unit { int pm, pn; };
struct Gemm { const bf16_t* A; const bf16_t* Bt; int M, N, K; };

struct StaticOrder {
    int nM, nN, nwg, G, c;
    __host__ __device__ void init(int M, int N, int G_, int c_) { nM = M / BM; nN = N / BM; nwg = nM * nN; G = G_; c = c_; }
    __host__ __device__ bool next(int i, Unit& u) const {
        const long L = (long)i * G + c; if (L >= nwg) return false;
        int wgid = (int)L; { const int q = nwg / NXCD, r = nwg % NXCD, xcd = wgid % NXCD, off = wgid / NXCD; wgid = (xcd < r ? xcd * (q + 1) : r * (q + 1) + (xcd - r) * q) + off; }
        const int nig = WGM * nN, gid = wgid / nig, fm = gid * WGM, gsz = (nM - fm) < WGM ? (nM - fm) : WGM;
        u.pm = fm + ((wgid % nig) % gsz); u.pn = (wgid % nig) / gsz; return true;
    }
    __device__ __forceinline__ void a_ready(const Unit&) const {}
    __device__ __forceinline__ void done(const Unit&) const {}
};

typedef unsigned u32x2 __attribute__((ext_vector_type(2)));
__device__ __forceinline__ unsigned cvt_pk_bf16(float lo, float hi) { unsigned r; asm volatile("v_cvt_pk_bf16_f32 %0, %1, %2" : "=v"(r) : "v"(lo), "v"(hi)); return r; }
constexpr float NORM_EPS = 1e-6f;
constexpr float QSCALE = 0.125f * 1.4426950408889634f;
__device__ __forceinline__ float row_rstd(const float* ssq, size_t row) {
    const f32x4* p = (const f32x4*)(ssq + row * 16); const f32x4 a = p[0], b = p[1], c = p[2], d = p[3];
    const float t = ((a[0] + a[1]) + (a[2] + a[3])) + ((b[0] + b[1]) + (b[2] + b[3])) + ((c[0] + c[1]) + (c[2] + c[3])) + ((d[0] + d[1]) + (d[2] + d[3]));
    return __builtin_amdgcn_rsqf(t * (1.0f / 1024.0f) + NORM_EPS);
}
__device__ __forceinline__ float row_ssq4(const float* ssq, size_t row, int fq) { const f32x4 a = ((const f32x4*)(ssq + row * 16))[fq]; return (a[0] + a[1]) + (a[2] + a[3]); }
__device__ __forceinline__ float rstd_fin(float t) { t += __shfl_xor(t, 16); t += __shfl_xor(t, 32); return __builtin_amdgcn_rsqf(t * (1.0f / 1024.0f) + NORM_EPS); }
template <int VMODE> struct EpiQKV {
    static constexpr bool PERM = true, AFTER_DRAIN = false, PERM_A = (VMODE == 0); static constexpr int vmode = VMODE, rope_on = VMODE, RM = PERM_A ? 1 : 16, RF = PERM_A ? 4 : 1;
    bf16_t* Q; bf16_t* Kb; bf16_t* Vt; const float* ssq; const float* rope;
    __device__ __forceinline__ void operator()(const f32x4 (&acc)[2][2][4][2], const Unit& u, int wr, int wc, int fr, int fq) const {
        asm volatile("" : "+v"(fr), "+v"(fq));
        const int type = u.pn >> 2, head = (u.pn & 3) * 4 + wc;
        const int b = u.pm >> 4, s0 = (u.pm & 15) * 256 + wr * 64 + RF * fr;
        const size_t row0 = (size_t)u.pm * 256 + wr * 64 + RF * fr;
        if (type < 2) {
            bf16_t* base = (type == 0) ? Q : Kb; const float sc = (type == 0) ? QSCALE : 1.0f;
            float rs[8];
#pragma unroll
            for (int t = 0; t < 8; ++t) rs[t] = row_ssq4(ssq, row0 + (t >> 2) * 128 + (t & 3) * RM, fq);
#pragma unroll
            for (int t = 0; t < 8; ++t) rs[t] = rstd_fin(rs[t]) * sc;
            f32x4 cs[2][2], sn[2][2];
            if (rope_on) { const float* rp = rope + (size_t)s0 * 64 + 8 * fq;
#pragma unroll
                for (int n = 0; n < 2; ++n) { cs[0][n] = *(const f32x4*)(rp + 4 * n); sn[0][n] = *(const f32x4*)(rp + 32 + 4 * n); } }
#pragma unroll
            for (int t = 0; t < 8; ++t) {
                const int ai = t >> 2, m = t & 3, cur = t & 1, nxt = cur ^ 1;
                const size_t row = row0 + ai * 128 + m * RM; const int s = s0 + ai * 128 + m * RM; const float f = rs[t];
                if (rope_on && t < 7) { const float* rp = rope + (size_t)(s0 + ((t + 1) >> 2) * 128 + ((t + 1) & 3) * RM) * 64 + 8 * fq;
#pragma unroll
                    for (int n = 0; n < 2; ++n) { cs[nxt][n] = *(const f32x4*)(rp + 4 * n); sn[nxt][n] = *(const f32x4*)(rp + 32 + 4 * n); } }
                f32x4 lo[2], hi[2];
#pragma unroll
                for (int n = 0; n < 2; ++n) { lo[n] = acc[ai][0][m][n] * f; hi[n] = acc[ai][1][m][n] * f; }
                if (rope_on) {
#pragma unroll
                    for (int n = 0; n < 2; ++n) { const f32x4 a1 = lo[n], a2 = hi[n]; lo[n] = a1 * cs[cur][n] - a2 * sn[cur][n]; hi[n] = a2 * cs[cur][n] + a1 * sn[cur][n]; } }
                bf16_t* dst; int hoff;
                if (type == 1 && vmode == 1) { dst = base + ((size_t)((b * 16 + head) * 16 + fr) * 32 + (u.pm & 15) * 2 + ai) * 512 + (fq * 8 + 4 * wr + m) * 8; hoff = 256; }
                else if (type == 1) {
                    const int kk = s & 31, mrow = 8 * ((kk >> 2) & 3) + 4 * (kk >> 4) + (kk & 3);
                    dst = base + ((size_t)(b * 16 + head) * 128 + (s >> 5)) * 2048 + (fq >> 1) * 512 + ((fq & 1) * 32 + mrow) * 8; hoff = 1024; }
                else { dst = base + row * 1024 + head * 64 + 8 * fq; hoff = 32; }
                u32x4 w; w.x = cvt_pk_bf16(lo[0][0], lo[0][1]); w.y = cvt_pk_bf16(lo[0][2], lo[0][3]); w.z = cvt_pk_bf16(lo[1][0], lo[1][1]); w.w = cvt_pk_bf16(lo[1][2], lo[1][3]);
                *(u32x4*)dst = w;
                w.x = cvt_pk_bf16(hi[0][0], hi[0][1]); w.y = cvt_pk_bf16(hi[0][2], hi[0][3]); w.z = cvt_pk_bf16(hi[1][0], hi[1][1]); w.w = cvt_pk_bf16(hi[1][2], hi[1][3]);
                *(u32x4*)(dst + hoff) = w;
                if (rope_on) asm volatile("" ::: "memory");
            }
        } else {
            bf16_t* vb = Vt + ((size_t)(b * 16 + head) * 64) * 4096;
            float rstd[2][4];
#pragma unroll
            for (int ai = 0; ai < 2; ++ai)
#pragma unroll
                for (int m = 0; m < 4; ++m) rstd[ai][m] = row_ssq4(ssq, row0 + ai * 128 + m * RM, fq);
#pragma unroll
            for (int ai = 0; ai < 2; ++ai)
#pragma unroll
                for (int m = 0; m < 4; ++m) rstd[ai][m] = rstd_fin(rstd[ai][m]);
#pragma unroll
            for (int bj = 0; bj < 2; ++bj)
#pragma unroll
                for (int n = 0; n < 2; ++n)
#pragma unroll
                    for (int i = 0; i < 4; ++i) {
#pragma unroll
                        for (int ai = 0; ai < 2; ++ai) {
                            const float v0 = acc[ai][bj][0][n][i] * rstd[ai][0], v1 = acc[ai][bj][1][n][i] * rstd[ai][1], v2 = acc[ai][bj][2][n][i] * rstd[ai][2], v3 = acc[ai][bj][3][n][i] * rstd[ai][3];
                            const unsigned p01 = cvt_pk_bf16(v0, v1), p23 = cvt_pk_bf16(v2, v3);
                            if (vmode == 0) {
                                u32x2 w; w.x = p01; w.y = p23;
                                *(u32x2*)(vb + (size_t)((u.pm & 15) * 8 + 4 * ai + 2 * wr + (fr >> 3)) * 2048 + ((bj * 2 + ((fr >> 1) & 1)) * 64 + ((fr >> 2) & 1) * 32 + 8 * fq + 4 * n + i) * 8 + 4 * (fr & 1)) = w; }
                            else { u32x2 w; w.x = p01; w.y = p23;
                                *(u32x2*)(vb + ((size_t)fr * 32 + (u.pm & 15) * 2 + ai) * 512 + (32 * bj + 8 * fq + 4 * n + i) * 8 + wr * 4) = w; }
                        }
                    }
        }
    }
};
struct EpiRes {
    static constexpr bool PERM = true, AFTER_DRAIN = false, PERM_A = false;
    bf16_t* hb; float* ssq;
    __device__ __forceinline__ void operator()(const f32x4 (&acc)[2][2][4][2], const Unit& u, int wr, int wc, int fr, int fq) const {
        asm volatile("" : "+v"(fr), "+v"(fq));
        const int c0 = u.pn * 256 + wc * 32 + 8 * fq; const size_t row0 = (size_t)u.pm * 256 + wr * 64 + fr;
        u32x4 old[2][2];
#pragma unroll
        for (int bj = 0; bj < 2; ++bj) old[0][bj] = *(const u32x4*)(hb + row0 * 1024 + c0 + bj * 128);
#pragma unroll
        for (int t = 0; t < 8; ++t) {
            const int ai = t >> 2, m = t & 3, cur = t & 1, nxt = cur ^ 1;
            const size_t row = row0 + ai * 128 + m * 16; float ss = 0.f;
            if (t < 7) { const size_t rn = row0 + ((t + 1) >> 2) * 128 + ((t + 1) & 3) * 16;
#pragma unroll
                for (int bj = 0; bj < 2; ++bj) old[nxt][bj] = *(const u32x4*)(hb + rn * 1024 + c0 + bj * 128); }
#pragma unroll
            for (int bj = 0; bj < 2; ++bj) { const size_t off = row * 1024 + c0 + bj * 128; const u32x4 o = old[cur][bj];
                f32x4 h0 = acc[ai][bj][m][0], h1 = acc[ai][bj][m][1];
                h0[0] += __uint_as_float(o.x << 16); h0[1] += __uint_as_float(o.x & 0xffff0000u); h0[2] += __uint_as_float(o.y << 16); h0[3] += __uint_as_float(o.y & 0xffff0000u);
                h1[0] += __uint_as_float(o.z << 16); h1[1] += __uint_as_float(o.z & 0xffff0000u); h1[2] += __uint_as_float(o.w << 16); h1[3] += __uint_as_float(o.w & 0xffff0000u);
                u32x4 w; w.x = cvt_pk_bf16(h0[0], h0[1]); w.y = cvt_pk_bf16(h0[2], h0[3]); w.z = cvt_pk_bf16(h1[0], h1[1]); w.w = cvt_pk_bf16(h1[2], h1[3]); *(u32x4*)(hb + off) = w;
                ss += ((h0[0] * h0[0] + h0[1] * h0[1]) + (h0[2] * h0[2] + h0[3] * h0[3])) + ((h1[0] * h1[0] + h1[1] * h1[1]) + (h1[2] * h1[2] + h1[3] * h1[3])); }
            ss += __shfl_xor(ss, 16); ss += __shfl_xor(ss, 32);
            if (fq == 0) ssq[row * 16 + u.pn * 4 + wc] = ss;
            asm volatile("" ::: "memory");
        }
    }
};
struct EpiSwiGLU {
    static constexpr bool PERM = true, AFTER_DRAIN = false, PERM_A = false;
    bf16_t* act; const float* ssq;
    __device__ __forceinline__ void operator()(const f32x4 (&acc)[2][2][4][2], const Unit& u, int wr, int wc, int fr, int fq) const {
        asm volatile("" : "+v"(fr), "+v"(fq));
        const int col0 = u.pn * 128 + wc * 32 + 8 * fq; const size_t row0 = (size_t)u.pm * 256 + wr * 64 + fr;
        float rsv[8];
#pragma unroll
        for (int t = 0; t < 8; ++t) rsv[t] = row_ssq4(ssq, row0 + (t >> 2) * 128 + (t & 3) * 16, fq);
#pragma unroll
        for (int t = 0; t < 8; ++t) rsv[t] = rstd_fin(rsv[t]);
#pragma unroll
        for (int ai = 0; ai < 2; ++ai)
#pragma unroll
            for (int m = 0; m < 4; ++m) {
                const size_t row = row0 + ai * 128 + m * 16; const float rs = rsv[ai * 4 + m];
                float o[8];
#pragma unroll
                for (int n = 0; n < 2; ++n)
#pragma unroll
                    for (int i = 0; i < 4; ++i) { const float g = acc[ai][0][m][n][i] * rs, up = acc[ai][1][m][n][i] * rs;
                        const float sg = __builtin_amdgcn_rcpf(1.0f + __builtin_amdgcn_exp2f(-1.4426950408889634f * g)); o[4 * n + i] = g * sg * up; }
                u32x4 w; w.x = cvt_pk_bf16(o[0], o[1]); w.y = cvt_pk_bf16(o[2], o[3]); w.z = cvt_pk_bf16(o[4], o[5]); w.w = cvt_pk_bf16(o[6], o[7]);
                __builtin_nontemporal_store(w, (u32x4*)(act + row * 2816 + col0));
            }
    }
};

template <class Epi, class Sched, bool ALIGN_EPI = false, bool SP2 = false>
__device__ __forceinline__ void gemm_phase(PG8_LAS unsigned char* lds, const Gemm g, const Sched& S, const Epi& E) {
    int tid_l = threadIdx.x; asm volatile("" : "+v"(tid_l)); const int tid = tid_l, wid = __builtin_amdgcn_readfirstlane(tid >> 6), lane = tid & 63, wr = wid >> 2, wc = wid & 3, fr = lane & 15, fq = lane >> 4;
    const int K = g.K, nt = K / BK;
    unsigned voffA[2], voffB[2];
#pragma unroll
    for (int i = 0; i < 2; ++i) { int R, C; stage_rc(tid * 16 + i * 8192, R, C); const int Rb = Epi::PERM ? ((R & ~31) + perm32(R & 31)) : R;
        const int Ra = Epi::PERM_A ? ((R & ~63) + 4 * (R & 15) + ((R >> 4) & 3)) : R;
        voffA[i] = (unsigned)(Ra * K + C) * 2u; voffB[i] = (unsigned)(Rb * K + C) * 2u; }
    const size_t kstep = (size_t)(BK * 2);
    const size_t hstep = (size_t)HALF * K * 2;
    const size_t tstep = 2 * hstep;
    const unsigned ldsw = (unsigned)wid * 1024u;
    const int aoff = lds_byte(wr * 64 + fr, fq * 8), boff = lds_byte(wc * 32 + fr, fq * 8);
#define PG8_SA(b, h) (((b) * 2 + (h)) * HTB)
#define PG8_SB(b, h) ((4 + (b) * 2 + (h)) * HTB)
#define PG8_STAGE(bufoff, gbase, voff) do { _Pragma("unroll") for (int _i = 0; _i < 2; ++_i) \
        __builtin_amdgcn_global_load_lds((const unsigned*)((const char*)(gbase) + (voff)[_i]), (PG8_LAS unsigned*)(lds + (bufoff) + ldsw + _i * 8192), 16, 0, 0); } while (0)
#define PG8_LDA(dst, b, h) do { _Pragma("unroll") for (int m = 0; m < 4; ++m) _Pragma("unroll") for (int k = 0; k < 2; ++k) dst[m][k] = *(const PG8_LAS bf16x8*)(lds + PG8_SA(b, h) + aoff + m * 2048 + k * 1024); } while (0)
#define PG8_LDB(dst, b, h) do { _Pragma("unroll") for (int n = 0; n < 2; ++n) _Pragma("unroll") for (int k = 0; k < 2; ++k) dst[n][k] = *(const PG8_LAS bf16x8*)(lds + PG8_SB(b, h) + boff + n * 2048 + k * 1024); } while (0)
#define PG8_MMA(ai, bj, At, Bt) do { __builtin_amdgcn_s_setprio(1); _Pragma("unroll") for (int m = 0; m < 4; ++m) _Pragma("unroll") for (int n = 0; n < 2; ++n) _Pragma("unroll") for (int k = 0; k < 2; ++k) \
        acc[ai][bj][m][n] = __builtin_amdgcn_mfma_f32_16x16x32_bf16(Bt[n][k], At[m][k], acc[ai][bj][m][n], 0, 0, 0); __builtin_amdgcn_s_setprio(0); } while (0)
#define PG8_WAIT_V(n) asm volatile("s_waitcnt vmcnt(" #n ")" ::: "memory")
#define PG8_WAIT_L(n) asm volatile("s_waitcnt lgkmcnt(" #n ")" ::: "memory")
#define PG8_BAR __builtin_amdgcn_s_barrier()
#define PG8_SCHED __builtin_amdgcn_sched_barrier(0)
    Unit cur, nxt; int ui = 0;
    if (!S.next(0, cur)) return;
    f32x4 acc[2][2][4][2];
#pragma unroll
    for (int a = 0; a < 2; ++a)
#pragma unroll
        for (int b = 0; b < 2; ++b)
#pragma unroll
            for (int m = 0; m < 4; ++m)
#pragma unroll
                for (int n = 0; n < 2; ++n) acc[a][b][m][n] = (f32x4){0.f, 0.f, 0.f, 0.f};
    bf16x8 At[4][2], B0[2][2], B1[2][2];
    const char* cA = (const char*)g.A + (size_t)cur.pm * tstep; const char* cB = (const char*)g.Bt + (size_t)cur.pn * tstep;
    S.a_ready(cur);
    if constexpr (SP2) {
        PG8_STAGE(PG8_SB(0, 0), cB, voffB); PG8_STAGE(PG8_SB(0, 1), cB + hstep, voffB); PG8_STAGE(PG8_SA(0, 0), cA, voffA); PG8_STAGE(PG8_SA(0, 1), cA + hstep, voffA);
        if (wr == 1) PG8_BAR;
        PG8_WAIT_V(2); PG8_BAR;
        PG8_STAGE(PG8_SB(1, 0), cB + kstep, voffB); PG8_STAGE(PG8_SA(1, 0), cA + kstep, voffA); PG8_STAGE(PG8_SB(1, 1), cB + hstep + kstep, voffB);
        PG8_WAIT_V(6); PG8_BAR;
    } else {
        PG8_STAGE(PG8_SB(0, 0), cB, voffB); PG8_STAGE(PG8_SA(0, 0), cA, voffA); PG8_STAGE(PG8_SB(0, 1), cB + hstep, voffB); PG8_STAGE(PG8_SA(0, 1), cA + hstep, voffA);
        if (wr == 1) PG8_BAR;
        PG8_WAIT_V(4); PG8_BAR;
        PG8_STAGE(PG8_SB(1, 0), cB + kstep, voffB); PG8_STAGE(PG8_SA(1, 0), cA + kstep, voffA); PG8_STAGE(PG8_SB(1, 1), cB + hstep + kstep, voffB);
        PG8_WAIT_V(6); PG8_BAR;
    }
    for (;;) {
        const bool has_next = S.next(ui + 1, nxt);
        const char* nA = has_next ? (const char*)g.A + (size_t)nxt.pm * tstep : cA; const char* nB = has_next ? (const char*)g.Bt + (size_t)nxt.pn * tstep : cB;
        for (int t = 0; t < nt; t += 2) {
            const bool last = (t == nt - 2);
            const char* a1 = cA + (size_t)(t + 1) * kstep;
            const char* a2 = last ? nA : cA + (size_t)(t + 2) * kstep; const char* b2 = last ? nB : cB + (size_t)(t + 2) * kstep;
            const char* a3 = a2 + kstep; const char* b3 = b2 + kstep;
            if (last && has_next) S.a_ready(nxt);
            if constexpr (SP2) {
            PG8_LDB(B0, 0, 0); PG8_LDB(B1, 0, 1); PG8_SCHED; PG8_LDA(At, 0, 0); PG8_STAGE(PG8_SA(1, 1), a1 + hstep, voffA);
            PG8_WAIT_V(8); PG8_WAIT_L(0); PG8_BAR; PG8_MMA(0, 0, At, B0); PG8_MMA(0, 1, At, B1); PG8_BAR; PG8_SCHED;
            PG8_LDA(At, 0, 1); PG8_STAGE(PG8_SB(0, 0), b2, voffB); PG8_STAGE(PG8_SB(0, 1), b2 + hstep, voffB); PG8_STAGE(PG8_SA(0, 0), a2, voffA);
            PG8_WAIT_V(8); PG8_WAIT_L(0); PG8_BAR; PG8_MMA(1, 0, At, B0); PG8_MMA(1, 1, At, B1); PG8_BAR; PG8_SCHED;
            PG8_LDB(B0, 1, 0); PG8_LDB(B1, 1, 1); PG8_SCHED; PG8_LDA(At, 1, 0); PG8_STAGE(PG8_SA(0, 1), a2 + hstep, voffA);
            PG8_WAIT_V(8); PG8_WAIT_L(0); PG8_BAR; PG8_MMA(0, 0, At, B0); PG8_MMA(0, 1, At, B1); PG8_BAR; PG8_SCHED;
            PG8_LDA(At, 1, 1); PG8_STAGE(PG8_SB(1, 0), b3, voffB); PG8_STAGE(PG8_SB(1, 1), b3 + hstep, voffB); PG8_STAGE(PG8_SA(1, 0), a3, voffA);
            PG8_WAIT_V(8); PG8_WAIT_L(0); PG8_BAR; PG8_MMA(1, 0, At, B0); PG8_MMA(1, 1, At, B1); PG8_BAR; PG8_SCHED;
            } else {
            PG8_LDB(B0, 0, 0); PG8_SCHED; PG8_LDA(At, 0, 0); PG8_STAGE(PG8_SA(1, 1), a1 + hstep, voffA);
            PG8_WAIT_L(8); PG8_BAR; PG8_WAIT_L(0); PG8_MMA(0, 0, At, B0); PG8_BAR; PG8_SCHED;
            PG8_LDB(B1, 0, 1); PG8_STAGE(PG8_SB(0, 0), b2, voffB);
            PG8_BAR; PG8_WAIT_L(0); PG8_MMA(0, 1, At, B1); PG8_BAR;
            PG8_LDA(At, 0, 1); PG8_STAGE(PG8_SA(0, 0), a2, voffA);
            PG8_BAR; PG8_WAIT_L(0); PG8_MMA(1, 0, At, B0); PG8_BAR; PG8_SCHED;
            PG8_STAGE(PG8_SB(0, 1), b2 + hstep, voffB);
            PG8_WAIT_V(6); PG8_BAR; PG8_MMA(1, 1, At, B1); PG8_BAR;
            PG8_LDB(B0, 1, 0); PG8_SCHED; PG8_LDA(At, 1, 0); PG8_STAGE(PG8_SA(0, 1), a2 + hstep, voffA);
            PG8_WAIT_L(8); PG8_BAR; PG8_WAIT_L(0); PG8_MMA(0, 0, At, B0); PG8_BAR; PG8_SCHED;
            PG8_LDB(B1, 1, 1); PG8_STAGE(PG8_SB(1, 0), b3, voffB);
            PG8_BAR; PG8_WAIT_L(0); PG8_MMA(0, 1, At, B1); PG8_BAR;
            PG8_LDA(At, 1, 1); PG8_STAGE(PG8_SA(1, 0), a3, voffA);
            PG8_BAR; PG8_WAIT_L(0); PG8_MMA(1, 0, At, B0); PG8_BAR; PG8_SCHED;
            PG8_STAGE(PG8_SB(1, 1), b3 + hstep, voffB);
            PG8_WAIT_V(6); PG8_BAR; PG8_MMA(1, 1, At, B1); PG8_BAR;
            }
        }
        if constexpr (ALIGN_EPI) { if (wr == 0) PG8_BAR; }
        if constexpr (!Epi::AFTER_DRAIN) { E(acc, cur, wr, wc, fr, fq); S.done(cur); }
        if (!has_next) break;
#pragma unroll
        for (int a = 0; a < 2; ++a)
#pragma unroll
            for (int b = 0; b < 2; ++b)
#pragma unroll
                for (int m = 0; m < 4; ++m)
#pragma unroll
                    for (int n = 0; n < 2; ++n) acc[a][b][m][n] = (f32x4){0.f, 0.f, 0.f, 0.f};
        cur = nxt; cA = nA; cB = nB; ++ui;
        if constexpr (ALIGN_EPI) { if (wr == 1) PG8_BAR; }
    }
    PG8_WAIT_V(0);
    if constexpr (!ALIGN_EPI) { if (wr == 0) PG8_BAR; }
    PG8_BAR;
    if constexpr (Epi::AFTER_DRAIN) { E.fused(acc, cur, wr, wc, fr, fq, lds, wid, lane); S.done(cur); }
#undef PG8_SA
#undef PG8_SB
#undef PG8_STAGE
#undef PG8_LDA
#undef PG8_LDB
#undef PG8_MMA
#undef PG8_WAIT_V
#undef PG8_WAIT_L
#undef PG8_BAR
#undef PG8_SCHED
}
}
using pg8::bf16_t; using pg8::bf16x8; using pg8::f32x4; using pg8::u32x4; using pg8::u32x2; using pg8::cvt_pk_bf16;
typedef float f32x16 __attribute__((ext_vector_type(16)));
#define LAS __attribute__((address_space(3)))
constexpr int DM = 1024, NBATCH = 16, SEQ = 4096, NH = 16, HD = 64, DFF = 2816, MTOK = NBATCH * SEQ, DEPTH = 4;
constexpr size_t MiB = 1u << 20;
constexpr size_t WS_SSQ = 0, WS_ROPE = 4 * MiB, WS_BAR = 6 * MiB, BAR_BYTES = 16384;
constexpr size_t WS_WQKV_A = 8 * MiB, WS_WO_A = 20 * MiB, WS_WB2 = 24 * MiB, WS_WB3 = 30 * MiB, WS_WO_B = 32 * MiB, WS_WGU = 36 * MiB, WS_WDN = 80 * MiB;
constexpr size_t WS_HB = 104 * MiB, WS_QO = 232 * MiB, WS_K = 360 * MiB, WS_VT = 488 * MiB, WS_ACT = 616 * MiB, WS_END = 968 * MiB;
constexpr size_t SZ_WQKV = (size_t)3072 * 1024 * 2, SZ_WSQ = (size_t)1024 * 1024 * 2, SZ_WGU = (size_t)5632 * 1024 * 2, SZ_WDN = (size_t)1024 * 2816 * 2;
constexpr int BARW_OFF = 155584;
constexpr int LDS_BYTES = 155648;
constexpr int NPHASE = 22;
#ifndef PROBE
#define PROBE 0
#endif

struct TJob { const float* src; const float* gain; bf16_t* dst; int ld, col0, ncols, K, dst_row0, map; };
struct Args { const float* in[13]; float* out; unsigned char* ws; int ph_lo, ph_hi; };
typedef const __attribute__((address_space(4))) Args* ArgsP;
constexpr int NJOBS = 21;
__device__ __forceinline__ int job_items(int j) { if (j < 6) return (j % 3 == 0) ? 16 * 96 : 16 * 32; if (j == 7) return 16 * 64; if (j < 9) return 16 * 32; return ((j - 9) % 3 == 2) ? 44 * 32 : 16 * 88; }
__device__ __forceinline__ TJob get_job(ArgsP ap, int j) {
    TJob J; unsigned char* ws = ap->ws;
    const float* norm_mix = ap->in[1]; const float* norm_ffn = ap->in[8];
    if (j < 6) { const int L = j / 3, k = j % 3;
        if (k == 0) { J.src = ap->in[2] + (size_t)L * 1024 * 3072; J.gain = norm_mix + L * 1024; J.dst = (bf16_t*)(ws + WS_WQKV_A + L * SZ_WQKV); J.ld = 3072; J.ncols = 3072; J.K = 1024; J.map = 1; }
        else if (k == 1) { J.src = ap->in[3] + (size_t)L * 1024 * 1024; J.gain = nullptr; J.dst = (bf16_t*)(ws + WS_WO_A + L * SZ_WSQ); J.ld = 1024; J.ncols = 1024; J.K = 1024; J.map = 0; }
        else { J.src = ap->in[7] + (size_t)L * 1024 * 1024; J.gain = nullptr; J.dst = (bf16_t*)(ws + WS_WO_B + L * SZ_WSQ); J.ld = 1024; J.ncols = 1024; J.K = 1024; J.map = 0; }
        J.col0 = 0; J.dst_row0 = 0; return J; }
    if (j == 6) { J.src = ap->in[6]; J.gain = norm_mix + 2 * 1024; J.dst = (bf16_t*)(ws + WS_WB2); J.ld = 1024; J.col0 = 0; J.ncols = 1024; J.K = 1024; J.dst_row0 = 0; J.map = 1; return J; }
    if (j == 7) { J.src = ap->in[5]; J.gain = ap->in[4]; J.dst = (bf16_t*)(ws + WS_WB2); J.ld = 2048; J.col0 = 0; J.ncols = 2048; J.K = 1024; J.dst_row0 = 1024; J.map = 1; return J; }
    if (j == 8) { J.src = ap->in[6] + (size_t)1024 * 1024; J.gain = norm_mix + 3 * 1024; J.dst = (bf16_t*)(ws + WS_WB3); J.ld = 1024; J.col0 = 0; J.ncols = 1024; J.K = 1024; J.dst_row0 = 0; J.map = 1; return J; }
    { const int L = (j - 9) / 3, k = (j - 9) % 3; J.col0 = 0; J.dst_row0 = 0;
        if (k == 0) { J.src = ap->in[9] + (size_t)L * 1024 * 2816; J.gain = norm_ffn + L * 1024; J.dst = (bf16_t*)(ws + WS_WGU + L * SZ_WGU); J.ld = 2816; J.ncols = 2816; J.K = 1024; J.map = 2; }
        else if (k == 1) { J.src = ap->in[10] + (size_t)L * 1024 * 2816; J.gain = norm_ffn + L * 1024; J.dst = (bf16_t*)(ws + WS_WGU + L * SZ_WGU); J.ld = 2816; J.ncols = 2816; J.K = 1024; J.map = 3; }
        else { J.src = ap->in[11] + (size_t)L * 2816 * 1024; J.gain = nullptr; J.dst = (bf16_t*)(ws + WS_WDN + L * SZ_WDN); J.ld = 1024; J.ncols = 1024; J.K = 2816; J.map = 0; }
        return J; }
}

__device__ __forceinline__ int map_col(int c, int map) {
    if (map == 1) { const int p = c >> 8, hh = (c >> 6) & 3, bj = (c >> 5) & 1, tt = c & 31; return (p << 8) + (bj << 7) + (hh << 5) + tt; }
    if (map == 2) return ((c >> 7) << 8) + (c & 127);
    if (map == 3) return ((c >> 7) << 8) + 128 + (c & 127);
    return c;
}
__device__ __forceinline__ void transpose_item(const TJob& J, LAS float* scr, int item, int lane) {
    const int nblk = J.ncols / 32, kb = item / nblk, nb = item % nblk, k0 = 64 * kb, n0 = 32 * nb;
#pragma unroll
    for (int i = 0; i < 8; ++i) { const int kk = 8 * i + (lane >> 3), ch = lane & 7; const float g = J.gain ? J.gain[k0 + kk] : 1.0f;
        const f32x4 v = __builtin_nontemporal_load((const f32x4*)(J.src + (size_t)(k0 + kk) * J.ld + J.col0 + n0 + 4 * ch));
        *(LAS f32x4*)(scr + kk * 36 + 4 * ch) = v * g; }
    asm volatile("s_waitcnt lgkmcnt(0)" ::: "memory");
    const int c = lane & 7; const int drow = J.dst_row0 + map_col(n0, J.map);
#pragma unroll
    for (int j = 0; j < 4; ++j) { const int n = (lane >> 3) + 8 * j; const LAS float* s = scr + (8 * c) * 36 + n;
        u32x4 o; o.x = cvt_pk_bf16(s[0 * 36], s[1 * 36]); o.y = cvt_pk_bf16(s[2 * 36], s[3 * 36]); o.z = cvt_pk_bf16(s[4 * 36], s[5 * 36]); o.w = cvt_pk_bf16(s[6 * 36], s[7 * 36]);
        *(u32x4*)(J.dst + (size_t)(drow + n) * J.K + k0 + 8 * c) = o; }
    asm volatile("s_waitcnt lgkmcnt(0)" ::: "memory");
}
__device__ __forceinline__ float wave_sum(float v) {
#pragma unroll
    for (int o = 1; o < 64; o <<= 1) v += __shfl_xor(v, o);
    return v;
}
__device__ __forceinline__ void prologue(ArgsP ap, LAS unsigned char* lds, int gw, int ngw, int wave, int lane) {
    LAS float* scr = (LAS float*)(lds + wave * 16384);
    int total = 0;
    for (int j = 0; j < NJOBS; ++j) total += job_items(j);
    for (int it = gw; it < total; it += ngw) {
        int r = it, j = 0;
        for (; j < NJOBS; ++j) { const int n = job_items(j); if (r < n) break; r -= n; }
        const TJob J = get_job(ap, j);
        transpose_item(J, scr, r, lane);
    }
    float* rope = (float*)(ap->ws + WS_ROPE);
    for (int e = gw * 64 + lane; e < SEQ * 32; e += ngw * 64) { const int s = e >> 5, j = e & 31;
        const float inv = __builtin_amdgcn_exp2f(-(float)j * 0.41524101186092033f);
        const float ang = (float)s * inv; double rev = (double)ang * 0.15915494309189535; rev -= __builtin_floor(rev); const float rf = (float)rev;
        rope[s * 64 + j] = __builtin_amdgcn_cosf(rf); rope[s * 64 + 32 + j] = __builtin_amdgcn_sinf(rf); }
    bf16_t* hb = (bf16_t*)(ap->ws + WS_HB); float* ssq = (float*)(ap->ws + WS_SSQ); const float* xin = ap->in[0];
    for (int row = gw; row < MTOK; row += ngw) {
        const f32x4* xr = (const f32x4*)(xin + (size_t)row * DM) + lane; float ss = 0.f; f32x4 v[4];
#pragma unroll
        for (int j = 0; j < 4; ++j) { v[j] = xr[64 * j]; ss += (v[j][0] * v[j][0] + v[j][1] * v[j][1]) + (v[j][2] * v[j][2] + v[j][3] * v[j][3]); }
        ss = wave_sum(ss);
        u32x2* o = (u32x2*)(hb + (size_t)row * DM) + lane;
#pragma unroll
        for (int j = 0; j < 4; ++j) { u32x2 w; w.x = cvt_pk_bf16(v[j][0], v[j][1]); w.y = cvt_pk_bf16(v[j][2], v[j][3]); o[64 * j] = w; }
        if (lane < 16) ssq[(size_t)row * 16 + lane] = (lane == 0) ? ss : 0.f;
    }
}
__device__ __forceinline__ void final_norm(ArgsP ap, int gw, int ngw, int lane) {
    const float* ssq = (const float*)(ap->ws + WS_SSQ); float* outp = ap->out; const float* nf = ap->in[12]; const bf16_t* hb = (const bf16_t*)(ap->ws + WS_HB);
    f32x4 g[4];
#pragma unroll
    for (int j = 0; j < 4; ++j) g[j] = ((const f32x4*)nf)[lane + 64 * j];
    for (int row = gw; row < MTOK; row += ngw) {
        const float rs = pg8::row_rstd(ssq, (size_t)row);
        const u32x2* hr = (const u32x2*)(hb + (size_t)row * DM) + lane; f32x4* xr = (f32x4*)(outp + (size_t)row * DM) + lane;
#pragma unroll
        for (int j = 0; j < 4; ++j) { const u32x2 o = hr[64 * j]; f32x4 v;
            v[0] = __uint_as_float(o.x << 16); v[1] = __uint_as_float(o.x & 0xffff0000u); v[2] = __uint_as_float(o.y << 16); v[3] = __uint_as_float(o.y & 0xffff0000u);
            xr[64 * j] = v * rs * g[j]; }
    }
}

__device__ __forceinline__ bf16x8 pack8(const float* w) {
    u32x4 p; p.x = cvt_pk_bf16(w[0], w[1]); p.y = cvt_pk_bf16(w[2], w[3]); p.z = cvt_pk_bf16(w[4], w[5]); p.w = cvt_pk_bf16(w[6], w[7]);
    return __builtin_bit_cast(bf16x8, p);
}
__device__ __forceinline__ void store_o(bf16_t* orow, const f32x16& o0, const f32x16& o1, float sc, int hi) {
#pragma unroll
    for (int g = 0; g < 4; ++g) {
        u32x2 w; w.x = cvt_pk_bf16(o0[4 * g] * sc, o0[4 * g + 1] * sc); w.y = cvt_pk_bf16(o0[4 * g + 2] * sc, o0[4 * g + 3] * sc); *(u32x2*)(orow + 8 * g + 4 * hi) = w;
        w.x = cvt_pk_bf16(o1[4 * g] * sc, o1[4 * g + 1] * sc); w.y = cvt_pk_bf16(o1[4 * g + 2] * sc, o1[4 * g + 3] * sc); *(u32x2*)(orow + 32 + 8 * g + 4 * hi) = w;
    }
}
constexpr int SCR_PITCH = 144, SCR_BYTES = 32 * SCR_PITCH, SCR_OFF = 40960;
__device__ __forceinline__ void rows_to_lds(LAS unsigned char* scr, const bf16_t* base, int t0, int ts, int lane) {
#pragma unroll
    for (int k = 0; k < 4; ++k) { const int row = 8 * k + (lane >> 3), ch = lane & 7; const u32x4 v = __builtin_nontemporal_load((const u32x4*)(base + (size_t)(t0 + ts * row) * DM + ch * 8)); *(LAS u32x4*)(scr + row * SCR_PITCH + ch * 16) = v; }
}
__device__ __forceinline__ void lds_to_rows(LAS unsigned char* scr, bf16_t* base, int t0, int ts, int lane) {
#pragma unroll
    for (int k = 0; k < 4; ++k) { const int row = 8 * k + (lane >> 3), ch = lane & 7; const u32x4 v = *(LAS u32x4*)(scr + row * SCR_PITCH + ch * 16); *(u32x4*)(base + (size_t)(t0 + ts * row) * DM + ch * 8) = v; }
}
__device__ __forceinline__ void o_to_lds(LAS unsigned char* scr, const f32x16& o0, const f32x16& o1, float sc, int r32, int hi) {
#pragma unroll
    for (int g = 0; g < 4; ++g) {
        u32x2 w; w.x = cvt_pk_bf16(o0[4 * g] * sc, o0[4 * g + 1] * sc); w.y = cvt_pk_bf16(o0[4 * g + 2] * sc, o0[4 * g + 3] * sc); *(LAS u32x2*)(scr + r32 * SCR_PITCH + (8 * g + 4 * hi) * 2) = w;
        w.x = cvt_pk_bf16(o1[4 * g] * sc, o1[4 * g + 1] * sc); w.y = cvt_pk_bf16(o1[4 * g + 2] * sc, o1[4 * g + 3] * sc); *(LAS u32x2*)(scr + r32 * SCR_PITCH + (32 + 8 * g + 4 * hi) * 2) = w;
    }
}
__device__ __forceinline__ void sb_unit(const bf16_t* Q, const bf16_t* Kb, const bf16_t* Vt, bf16_t* O, int bh, int qb, int lane, int cap = 1 << 30) {
    const int b = bh >> 4, h = bh & 15, r32 = lane & 31, hi = lane >> 5;
    const size_t rowbase = (size_t)b * SEQ;
    const bf16_t* qp = Q + (rowbase + qb * 32 + r32) * DM + h * HD + 8 * hi;
    bf16x8 qf[4];
#pragma unroll
    for (int s = 0; s < 4; ++s) qf[s] = *(const bf16x8*)(qp + 16 * s);
    const bf16_t* kp = Kb + (size_t)bh * (128 * 2048) + lane * 8;
    const bf16_t* vp = Vt + (size_t)bh * (128 * 2048) + lane * 8;
    f32x16 o0 = {}, o1 = {}; float P = 1.0f;
    bf16x8 kA[4], vA[4], kB[4], vB[4], kC[4], vC[4];
#define SB_LOAD(KF, VF, JT) do { { const int jt_ = (JT) < 0 ? 0 : (JT); const bf16_t* kt_ = kp + jt_ * 2048; const bf16_t* vt_ = vp + jt_ * 2048; \
        _Pragma("unroll") for (int s = 0; s < 4; ++s) { KF[s] = *(const bf16x8*)(kt_ + 512 * s); VF[s] = *(const bf16x8*)(vt_ + 512 * s); } } } while (0)
#define SB_STEP(KF, VF, JT) do { \
        f32x16 S = {}; \
        _Pragma("unroll") for (int s = 0; s < 4; ++s) S = __builtin_amdgcn_mfma_f32_32x32x16_bf16(KF[s], qf[s], S, 0, 0, 0); \
        float r[16]; const bool diag = ((JT) == qb); \
        _Pragma("unroll") for (int i = 0; i < 16; ++i) { float e = __builtin_amdgcn_exp2f(S[i]); if (diag && (16 * hi + i >= r32)) e = 0.f; r[i] = __builtin_amdgcn_rcpf(1.0f + e); } \
        const float t8a = ((r[8] * r[9]) * (r[10] * r[11])) * ((r[12] * r[13]) * (r[14] * r[15])), t8b = ((r[0] * r[1]) * (r[2] * r[3])) * ((r[4] * r[5]) * (r[6] * r[7])), tot = t8a * t8b; \
        auto rr = __builtin_amdgcn_permlane32_swap(__float_as_uint(tot), __float_as_uint(tot), false, false); \
        const float tot_lo = __uint_as_float(rr[0]), tot_hi = __uint_as_float(rr[1]); \
        float A = hi ? P : P * tot_hi; float B2 = A * t8a; P = P * tot_lo * tot_hi; float w[16];        \
        _Pragma("unroll") for (int i = 7; i >= 0; --i) { const float An = A * r[8 + i]; w[8 + i] = A - An; A = An; const float Bn = B2 * r[i]; w[i] = B2 - Bn; B2 = Bn; } \
        const bf16x8 p0 = pack8(w), p1 = pack8(w + 8); \
        o0 = __builtin_amdgcn_mfma_f32_32x32x16_bf16(VF[0], p0, o0, 0, 0, 0); o0 = __builtin_amdgcn_mfma_f32_32x32x16_bf16(VF[1], p1, o0, 0, 0, 0); \
        o1 = __builtin_amdgcn_mfma_f32_32x32x16_bf16(VF[2], p0, o1, 0, 0, 0); o1 = __builtin_amdgcn_mfma_f32_32x32x16_bf16(VF[3], p1, o1, 0, 0, 0); } while (0)
    SB_LOAD(kA, vA, qb); SB_LOAD(kB, vB, qb - 1);
    for (int jt = qb; jt >= 0 && jt > qb - cap; jt -= 3) {
        SB_LOAD(kC, vC, jt - 2); SB_STEP(kA, vA, jt);     if (jt - 1 < 0 || __ballot(P != 0.0f) == 0ull) break;
        SB_LOAD(kA, vA, jt - 3); SB_STEP(kB, vB, jt - 1); if (jt - 2 < 0 || __ballot(P != 0.0f) == 0ull) break;
        SB_LOAD(kB, vB, jt - 4); SB_STEP(kC, vC, jt - 2); if (__ballot(P != 0.0f) == 0ull) break;
    }
#undef SB_LOAD
#undef SB_STEP
    store_o(O + (rowbase + qb * 32 + r32) * DM + h * HD, o0, o1, 1.0f, hi);
}

struct DTile { int cb, cs, ibase, is, wr, valid; };
template <int MODE> __device__ __forceinline__ DTile dil_decode(int tt, int c, int ib) {
    DTile d;
    if (MODE == 0) { const int w = (ib >> 2) - 1 + (tt >> 2); d.cb = 4 * (tt & 3); d.cs = 1; d.ibase = 8 * w; d.is = 0; d.wr = 128; d.valid = w >= 0; }
    else if (tt < 5) { const int w = ib - 4 + tt; d.cb = c; d.cs = 0; d.ibase = 32 * w; d.is = 8; d.wr = 2048; d.valid = w >= 0; }
    else { const int w = 4 * ib - 4 + (tt - 5); d.cb = c & 3; d.cs = 4; d.ibase = 8 * w; d.is = 0; d.wr = 512; d.valid = w >= 0; }
    return d;
}
__device__ __forceinline__ void dil_load(const DTile& d, const bf16_t* kq, const bf16_t* vq, int rho_m, int j_m, int hi, bf16x8* kf, bf16x8* vf) {
    const int ib0 = d.valid ? d.ibase : 0;
    const bf16_t* kt = kq + (size_t)((d.cb + d.cs * rho_m) * 32 + ((ib0 + d.is * rho_m) >> 3)) * 512;
#pragma unroll
    for (int s = 0; s < 4; ++s) kf[s] = *(const bf16x8*)(kt + s * 128);
#pragma unroll
    for (int u = 0; u < 2; ++u) { const int rho = 2 * hi + u; const bf16_t* vt = vq + (size_t)((d.cb + d.cs * rho) * 32 + ((ib0 + d.is * rho) >> 3)) * 512;
        vf[u] = *(const bf16x8*)(vt); vf[2 + u] = *(const bf16x8*)(vt + 256); }
}
__device__ __forceinline__ void dil_load_u(const bf16_t* kbh, const bf16_t* vbh, unsigned sbase, unsigned kro, unsigned vro0, unsigned vro1, bf16x8* kf, bf16x8* vf) {
    const bf16_t* kt = kbh + sbase; const bf16_t* vt = vbh + sbase;
#pragma unroll
    for (int s = 0; s < 4; ++s) kf[s] = *(const bf16x8*)(kt + (kro + s * 128));
    vf[0] = *(const bf16x8*)(vt + vro0); vf[1] = *(const bf16x8*)(vt + vro1); vf[2] = *(const bf16x8*)(vt + (vro0 + 256)); vf[3] = *(const bf16x8*)(vt + (vro1 + 256));
}
template <int MODE> __device__ __forceinline__ void dil_unit(const bf16_t* Q, const bf16_t* Kb, const bf16_t* Vt, bf16_t* O, bf16_t* X1, float* LSE, int bh, int c, int ib, int lane, LAS unsigned char* scr, int ntcap = 64) {
    constexpr int NT = MODE == 0 ? 8 : 13;
    const int b = bh >> 4, h = bh & 15, r32 = lane & 31, hi = lane >> 5;
    const size_t rowbase = (size_t)b * SEQ;
    const int tq = MODE == 0 ? 32 * ib + r32 : c + 16 * (32 * ib + r32);
    const int t0 = MODE == 0 ? 32 * ib : c + 512 * ib, ts = MODE == 0 ? 1 : 16;
    rows_to_lds(scr, Q + rowbase * DM + h * HD, t0, ts, lane);
    bf16x8 qf[4];
#pragma unroll
    for (int s = 0; s < 4; ++s) qf[s] = *(LAS bf16x8*)(scr + r32 * SCR_PITCH + (2 * s + hi) * 16);
    const int u_m = (r32 >> 4) & 1, hi_m = (r32 >> 2) & 1, j_m = (r32 & 3) + 4 * ((r32 >> 3) & 1), rho_m = 2 * hi_m + u_m;
    const bf16_t* kq = Kb + (size_t)bh * (16 * 32 * 512) + (8 * hi + j_m) * 8;
    const bf16_t* vq = Vt + (size_t)bh * (16 * 32 * 512) + r32 * 8;
    f32x16 o0 = {}, o1 = {}; float mrun = -1e30f, l = 0.f;
    bf16x8 kA[4], vA[4], kB[4], vB[4], kC[4], vC[4];
    const bf16_t* kbh = Kb + (size_t)bh * (16 * 32 * 512); const bf16_t* vbh = Vt + (size_t)bh * (16 * 32 * 512);
    const unsigned kl_ = (unsigned)((8 * hi + j_m) * 8), vl_ = (unsigned)(r32 * 8);
    const unsigned kro16 = kl_ + rho_m * 512u, kro4 = kl_ + rho_m * 65536u, vro16 = vl_ + (2 * hi) * 512u, vro4 = vl_ + (2 * hi) * 65536u;
#define DL_LOAD(KF, VF, TT) do { const int tt_ = (TT) < NT ? (TT) : NT - 1; \
        if (MODE == 1) { const bool r16_ = tt_ < 5; const int w_ = r16_ ? ib - 4 + tt_ : 4 * ib - 4 + (tt_ - 5); const int wc_ = w_ < 0 ? 0 : w_; \
            const unsigned sb_ = r16_ ? (unsigned)((c * 32 + 4 * wc_) * 512) : (unsigned)(((c & 3) * 32 + wc_) * 512); \
            dil_load_u(kbh, vbh, sb_, r16_ ? kro16 : kro4, r16_ ? vro16 : vro4, r16_ ? vro16 + 512u : vro4 + 65536u, KF, VF); } \
        else { const DTile d_ = dil_decode<MODE>(tt_, c, ib); dil_load(d_, kq, vq, rho_m, j_m, hi, KF, VF); } } while (0)
#define DL_STEP(KF, VF, TT) do { const DTile dc = dil_decode<MODE>((TT), c, ib); if ((TT) < NT && (TT) < ntcap && dc.valid) { \
        f32x16 S = {}; \
        _Pragma("unroll") for (int s = 0; s < 4; ++s) S = __builtin_amdgcn_mfma_f32_32x32x16_bf16(KF[s], qf[s], S, 0, 0, 0); \
        const int stride = 16 * dc.is + dc.cs; const int dA = tq - 16 * dc.ibase - dc.cb - 2 * hi * stride, dB = dA - stride; \
        float z[16]; \
        _Pragma("unroll") for (int i = 0; i < 16; ++i) { const bool ok = (unsigned)(((i >> 3) ? dB : dA) - 16 * (i & 7)) <= (unsigned)dc.wr; z[i] = ok ? S[i] : -INFINITY; } \
        float mx = __builtin_fmaxf(__builtin_fmaxf(__builtin_fmaxf(__builtin_fmaxf(z[0], z[1]), __builtin_fmaxf(z[2], z[3])), __builtin_fmaxf(__builtin_fmaxf(z[4], z[5]), __builtin_fmaxf(z[6], z[7]))), \
                                   __builtin_fmaxf(__builtin_fmaxf(__builtin_fmaxf(z[8], z[9]), __builtin_fmaxf(z[10], z[11])), __builtin_fmaxf(__builtin_fmaxf(z[12], z[13]), __builtin_fmaxf(z[14], z[15])))); \
        auto rr = __builtin_amdgcn_permlane32_swap(__float_as_uint(mx), __float_as_uint(mx), false, false); \
        mx = fmaxf(__uint_as_float(rr[0]), __uint_as_float(rr[1])); \
        if (__ballot(mx > mrun) != 0ull) { const float mnew = fmaxf(mrun, mx); const float alpha = __builtin_amdgcn_exp2f(mrun - mnew); mrun = mnew; l *= alpha; \
            _Pragma("unroll") for (int i = 0; i < 16; ++i) { o0[i] *= alpha; o1[i] *= alpha; } } \
        float p[16]; \
        _Pragma("unroll") for (int i = 0; i < 16; ++i) p[i] = __builtin_amdgcn_exp2f(z[i] - mrun); \
        l += (((p[0] + p[1]) + (p[2] + p[3])) + ((p[4] + p[5]) + (p[6] + p[7]))) + (((p[8] + p[9]) + (p[10] + p[11])) + ((p[12] + p[13]) + (p[14] + p[15]))); \
        const bf16x8 p0 = pack8(p), p1 = pack8(p + 8); \
        o0 = __builtin_amdgcn_mfma_f32_32x32x16_bf16(VF[0], p0, o0, 0, 0, 0); o0 = __builtin_amdgcn_mfma_f32_32x32x16_bf16(VF[1], p1, o0, 0, 0, 0); \
        o1 = __builtin_amdgcn_mfma_f32_32x32x16_bf16(VF[2], p0, o1, 0, 0, 0); o1 = __builtin_amdgcn_mfma_f32_32x32x16_bf16(VF[3], p1, o1, 0, 0, 0); } } while (0)
    DL_LOAD(kA, vA, 0); DL_LOAD(kB, vB, 1);
    for (int tt = 0; tt < NT; tt += 3) {
        DL_LOAD(kC, vC, tt + 2); DL_STEP(kA, vA, tt);
        DL_LOAD(kA, vA, tt + 3); DL_STEP(kB, vB, tt + 1);
        DL_LOAD(kB, vB, tt + 4); DL_STEP(kC, vC, tt + 2);
    }
#undef DL_LOAD
#undef DL_STEP
    auto rr = __builtin_amdgcn_permlane32_swap(__float_as_uint(l), __float_as_uint(l), false, false);
    const float lt = __uint_as_float(rr[0]) + __uint_as_float(rr[1]);
    const size_t orow = (rowbase + tq) * DM + h * HD;
    if (MODE == 0) {
        o_to_lds(scr, o0, o1, 1.0f / lt, r32, hi); lds_to_rows(scr, X1 + rowbase * DM + h * HD, t0, ts, lane);
        if (hi == 0) LSE[(rowbase + tq) * 16 + h] = mrun + __builtin_amdgcn_logf(lt);
    } else {
        rows_to_lds(scr, X1 + rowbase * DM + h * HD, t0, ts, lane);
        const float lse1 = LSE[(rowbase + tq) * 16 + h];
        const float M = fmaxf(mrun, lse1), w2 = __builtin_amdgcn_exp2f(mrun - M), w1 = __builtin_amdgcn_exp2f(lse1 - M), inv = 1.0f / (lt * w2 + w1), a2 = w2 * inv, a1 = w1 * inv;
#pragma unroll
        for (int g = 0; g < 4; ++g) {
            const u32x2 x0 = *(LAS u32x2*)(scr + r32 * SCR_PITCH + (8 * g + 4 * hi) * 2), x1 = *(LAS u32x2*)(scr + r32 * SCR_PITCH + (32 + 8 * g + 4 * hi) * 2);
            o0[4 * g] = o0[4 * g] * a2 + __uint_as_float(x0.x << 16) * a1; o0[4 * g + 1] = o0[4 * g + 1] * a2 + __uint_as_float(x0.x & 0xffff0000u) * a1;
            o0[4 * g + 2] = o0[4 * g + 2] * a2 + __uint_as_float(x0.y << 16) * a1; o0[4 * g + 3] = o0[4 * g + 3] * a2 + __uint_as_float(x0.y & 0xffff0000u) * a1;
            o1[4 * g] = o1[4 * g] * a2 + __uint_as_float(x1.x << 16) * a1; o1[4 * g + 1] = o1[4 * g + 1] * a2 + __uint_as_float(x1.x & 0xffff0000u) * a1;
            o1[4 * g + 2] = o1[4 * g + 2] * a2 + __uint_as_float(x1.y << 16) * a1; o1[4 * g + 3] = o1[4 * g + 3] * a2 + __uint_as_float(x1.y & 0xffff0000u) * a1;
        }
        o_to_lds(scr, o0, o1, 1.0f, r32, hi); lds_to_rows(scr, O + rowbase * DM + h * HD, t0, ts, lane);
    }
}


#define ATT_WAITBAR() asm volatile("s_waitcnt lgkmcnt(0)\n\ts_barrier" ::: "memory")
typedef LAS bf16x8* lds_v8;
__device__ __forceinline__ void sb_group(const bf16_t* Q, const bf16_t* Kb, const bf16_t* Vt, bf16_t* O, int bh, int g, int tid, LAS unsigned char* lds) {
    const int lane = tid & 63, wave = __builtin_amdgcn_readfirstlane(tid >> 6), r32 = lane & 31, hi = lane >> 5;
    const int b = bh >> 4, h = bh & 15, qb = 8 * g + wave, top = 8 * g + 7;
    const size_t rowbase = (size_t)b * SEQ;
    LAS unsigned char* scr = lds + SCR_OFF + wave * SCR_BYTES;
    rows_to_lds(scr, Q + rowbase * DM + h * HD, qb * 32, 1, lane);
    bf16x8 qf[4];
#pragma unroll
    for (int s = 0; s < 4; ++s) qf[s] = *(LAS bf16x8*)(scr + r32 * SCR_PITCH + (2 * s + hi) * 16);
    const bf16_t* src = ((tid < 256) ? Kb : Vt) + (size_t)bh * (128 * 2048) + (tid & 255) * 8;
    LAS unsigned char* dst = lds + tid * 16;
    LAS unsigned char* rdp = lds + lane * 16;
    volatile LAS unsigned* flags = (volatile LAS unsigned*)(lds + 32768);
#define SG_GLOAD(JT) (*(const bf16x8*)(src + (size_t)((JT) < 0 ? 0 : (JT)) * 2048))
    bf16x8 r0 = SG_GLOAD(top), r1 = SG_GLOAD(top - 1), rh = SG_GLOAD(top - 2);
    ATT_WAITBAR();
    *(lds_v8)(dst) = r0; *(lds_v8)(dst + 8192) = r1;
    f32x16 o0 = {}, o1 = {}; float P = 1.0f;
    for (int t = 0; ; ++t) {
        const int jt = top - t, slot = (t & 3) * 8192;
        const bf16x8 rn = SG_GLOAD(jt - 3);
        *(lds_v8)(dst + ((t + 2) & 3) * 8192) = rh;
        const bool mine = (jt <= qb) && (jt >= 0) && (__ballot(P != 0.0f) != 0ull);
        if (lane == 0) flags[(t & 1) * 8 + wave] = (jt >= 0 && (jt > qb || mine)) ? 1u : 0u;
        ATT_WAITBAR();
        { const u32x4 fa = *(LAS u32x4*)(lds + 32768 + (t & 1) * 32), fb = *(LAS u32x4*)(lds + 32768 + (t & 1) * 32 + 16);
          if (((fa.x | fa.y) | (fa.z | fa.w) | (fb.x | fb.y) | (fb.z | fb.w)) == 0u) break; }
        if (mine) {
            bf16x8 KF[4], VF[4];
#pragma unroll
            for (int s = 0; s < 4; ++s) { KF[s] = *(lds_v8)(rdp + slot + s * 1024); VF[s] = *(lds_v8)(rdp + slot + 4096 + s * 1024); }
            f32x16 S = {};
#pragma unroll
            for (int s = 0; s < 4; ++s) S = __builtin_amdgcn_mfma_f32_32x32x16_bf16(KF[s], qf[s], S, 0, 0, 0);
            float r[16]; const bool diag = (jt == qb);
#pragma unroll
            for (int i = 0; i < 16; ++i) { float e = __builtin_amdgcn_exp2f(S[i]); if (diag && (16 * hi + i >= r32)) e = 0.f; r[i] = __builtin_amdgcn_rcpf(1.0f + e); }
            const float t8a = ((r[8] * r[9]) * (r[10] * r[11])) * ((r[12] * r[13]) * (r[14] * r[15])), t8b = ((r[0] * r[1]) * (r[2] * r[3])) * ((r[4] * r[5]) * (r[6] * r[7])), tot = t8a * t8b;
            auto rr = __builtin_amdgcn_permlane32_swap(__float_as_uint(tot), __float_as_uint(tot), false, false);
            const float tot_lo = __uint_as_float(rr[0]), tot_hi = __uint_as_float(rr[1]);
            float A = hi ? P : P * tot_hi; float B2 = A * t8a; P = P * tot_lo * tot_hi; float w[16];
#pragma unroll
            for (int i = 7; i >= 0; --i) { const float An = A * r[8 + i]; w[8 + i] = A - An; A = An; const float Bn = B2 * r[i]; w[i] = B2 - Bn; B2 = Bn; }
            const bf16x8 p0 = pack8(w), p1 = pack8(w + 8);
            o0 = __builtin_amdgcn_mfma_f32_32x32x16_bf16(VF[0], p0, o0, 0, 0, 0); o0 = __builtin_amdgcn_mfma_f32_32x32x16_bf16(VF[1], p1, o0, 0, 0, 0);
            o1 = __builtin_amdgcn_mfma_f32_32x32x16_bf16(VF[2], p0, o1, 0, 0, 0); o1 = __builtin_amdgcn_mfma_f32_32x32x16_bf16(VF[3], p1, o1, 0, 0, 0);
        }
        rh = rn;
    }
#undef SG_GLOAD
    o_to_lds(scr, o0, o1, 1.0f, r32, hi);
    lds_to_rows(scr, O + rowbase * DM + h * HD, qb * 32, 1, lane);
}
constexpr int SBW_TILES = 14, SBW_SCR = SBW_TILES * 8192;
__device__ __forceinline__ void sb_step(const bf16x8* KF, const bf16x8* VF, const bf16x8* qf, f32x16& o0, f32x16& o1, float& P, bool diag, int r32, int hi) {
    f32x16 S = {};
#pragma unroll
    for (int s = 0; s < 4; ++s) S = __builtin_amdgcn_mfma_f32_32x32x16_bf16(KF[s], qf[s], S, 0, 0, 0);
    float r[16];
#pragma unroll
    for (int i = 0; i < 16; ++i) { float e = __builtin_amdgcn_exp2f(S[i]); if (diag && (16 * hi + i >= r32)) e = 0.f; r[i] = __builtin_amdgcn_rcpf(1.0f + e); }
    const float t8a = ((r[8] * r[9]) * (r[10] * r[11])) * ((r[12] * r[13]) * (r[14] * r[15])), t8b = ((r[0] * r[1]) * (r[2] * r[3])) * ((r[4] * r[5]) * (r[6] * r[7])), tot = t8a * t8b;
    auto rr = __builtin_amdgcn_permlane32_swap(__float_as_uint(tot), __float_as_uint(tot), false, false);
    const float tot_lo = __uint_as_float(rr[0]), tot_hi = __uint_as_float(rr[1]);
    float A = hi ? P : P * tot_hi; float B2 = A * t8a; P = P * tot_lo * tot_hi; float w[16];
#pragma unroll
    for (int i = 7; i >= 0; --i) { const float An = A * r[8 + i]; w[8 + i] = A - An; A = An; const float Bn = B2 * r[i]; w[i] = B2 - Bn; B2 = Bn; }
    const bf16x8 p0 = pack8(w), p1 = pack8(w + 8);
    o0 = __builtin_amdgcn_mfma_f32_32x32x16_bf16(VF[0], p0, o0, 0, 0, 0); o0 = __builtin_amdgcn_mfma_f32_32x32x16_bf16(VF[1], p1, o0, 0, 0, 0);
    o1 = __builtin_amdgcn_mfma_f32_32x32x16_bf16(VF[2], p0, o1, 0, 0, 0); o1 = __builtin_amdgcn_mfma_f32_32x32x16_bf16(VF[3], p1, o1, 0, 0, 0);
}
__device__ __forceinline__ void sb_groups(const bf16_t* Q, const bf16_t* Kb, const bf16_t* Vt, bf16_t* O, int bid, int G, int tid, LAS unsigned char* lds) {
    const int lane = tid & 63, wave = __builtin_amdgcn_readfirstlane(tid >> 6), r32 = lane & 31, hi = lane >> 5;
    LAS unsigned char* scr = lds + SBW_SCR + wave * SCR_BYTES;
    LAS unsigned char* wdst = lds + tid * 16;
    LAS unsigned char* rdp = lds + lane * 16;
    bf16x8 W[SBW_TILES]; u32x4 QR[4];
#define SBW_ITEM(U, BH, GR) const int BH = (U) & 255, GR = (((U) >> 8) & 1) ? 15 - ((U) >> 9) : ((U) >> 9)
#define SBW_PREFETCH(U) do { SBW_ITEM(U, bh_, g_); const int top_ = 8 * g_ + 7; \
        const bf16_t* src_ = ((tid < 256) ? Kb : Vt) + (size_t)bh_ * (128 * 2048) + (tid & 255) * 8; \
        _Pragma("unroll") for (int k = 0; k < SBW_TILES; ++k) { const int jt_ = top_ - k; W[k] = *(const bf16x8*)(src_ + (size_t)(jt_ < 0 ? 0 : jt_) * 2048); } \
        const bf16_t* qb_ = Q + ((size_t)(bh_ >> 4) * SEQ) * DM + (bh_ & 15) * HD; \
        _Pragma("unroll") for (int k = 0; k < 4; ++k) QR[k] = __builtin_nontemporal_load((const u32x4*)(qb_ + (size_t)((8 * g_ + wave) * 32 + 8 * k + (lane >> 3)) * DM + (lane & 7) * 8)); } while (0)
    if (bid < 4096) SBW_PREFETCH(bid);
    for (int unit = bid; unit < 4096; unit += G) {
        SBW_ITEM(unit, bh, g);
        const int b = bh >> 4, h = bh & 15, qb = 8 * g + wave, top = 8 * g + 7, wlo = top - (SBW_TILES - 1);
        const size_t rowbase = (size_t)b * SEQ;
        ATT_WAITBAR();
#pragma unroll
        for (int k = 0; k < SBW_TILES; ++k) *(lds_v8)(wdst + k * 8192) = W[k];
#pragma unroll
        for (int k = 0; k < 4; ++k) *(LAS u32x4*)(scr + (8 * k + (lane >> 3)) * SCR_PITCH + (lane & 7) * 16) = QR[k];
        ATT_WAITBAR();
        if (unit + G < 4096) SBW_PREFETCH(unit + G);
        bf16x8 qf[4];
#pragma unroll
        for (int s = 0; s < 4; ++s) qf[s] = *(LAS bf16x8*)(scr + r32 * SCR_PITCH + (2 * s + hi) * 16);
        f32x16 o0 = {}, o1 = {}; float P = 1.0f; int jt = qb;
        for (; jt >= 0 && jt >= wlo; --jt) {
            const int slot = (top - jt) * 8192; bf16x8 KF[4], VF[4];
#pragma unroll
            for (int s = 0; s < 4; ++s) { KF[s] = *(lds_v8)(rdp + slot + s * 1024); VF[s] = *(lds_v8)(rdp + slot + 4096 + s * 1024); }
            sb_step(KF, VF, qf, o0, o1, P, jt == qb, r32, hi);
            if (__ballot(P != 0.0f) == 0ull) { jt = -1; break; }
        }
        for (; jt >= 0; --jt) {
            const bf16_t* kt = Kb + (size_t)bh * (128 * 2048) + (size_t)jt * 2048 + lane * 8; const bf16_t* vt = Vt + (size_t)bh * (128 * 2048) + (size_t)jt * 2048 + lane * 8; bf16x8 KF[4], VF[4];
#pragma unroll
            for (int s = 0; s < 4; ++s) { KF[s] = *(const bf16x8*)(kt + 512 * s); VF[s] = *(const bf16x8*)(vt + 512 * s); }
            sb_step(KF, VF, qf, o0, o1, P, false, r32, hi);
            if (__ballot(P != 0.0f) == 0ull) break;
        }
        o_to_lds(scr, o0, o1, 1.0f, r32, hi);
        lds_to_rows(scr, O + rowbase * DM + h * HD, qb * 32, 1, lane);
    }
#undef SBW_ITEM
#undef SBW_PREFETCH
}
__device__ __forceinline__ void dil_group0(const bf16_t* Q, const bf16_t* Kb, const bf16_t* Vt, bf16_t* X1, float* LSE, int bh, int g, int tid, LAS unsigned char* lds) {
    const int lane = tid & 63, wave = __builtin_amdgcn_readfirstlane(tid >> 6), r32 = lane & 31, hi = lane >> 5;
    const int b = bh >> 4, h = bh & 15, blk = 8 * g + wave, tq = 32 * blk + r32, vlo = wave >> 2;
    const size_t rowbase = (size_t)b * SEQ;
    LAS unsigned char* scr = lds + SCR_OFF + wave * SCR_BYTES;
    rows_to_lds(scr, Q + rowbase * DM + h * HD, 32 * blk, 1, lane);
    bf16x8 qf[4];
#pragma unroll
    for (int s = 0; s < 4; ++s) qf[s] = *(LAS bf16x8*)(scr + r32 * SCR_PITCH + (2 * s + hi) * 16);
    const int u_m = (r32 >> 4) & 1, hi_m = (r32 >> 2) & 1, j_m = (r32 & 3) + 4 * ((r32 >> 3) & 1), rho_m = 2 * hi_m + u_m;
    const int part = tid >> 6, rho_s = part & 3;
    const bf16_t* src = ((part < 4) ? Kb : Vt) + (size_t)bh * (16 * 32 * 512) + (size_t)rho_s * (32 * 512) + (tid & 63) * 8;
    LAS unsigned char* dst = lds + part * 1024 + (tid & 63) * 16;
    LAS unsigned char* krd = lds + rho_m * 1024 + (hi * 8 + j_m) * 16;
    LAS unsigned char* vrd = lds + 4096 + (2 * hi) * 1024 + r32 * 16;
#define DG_GLOAD(T) (*(const bf16x8*)(src + (size_t)((((T) < 12 ? (T) : 11) & 3) * 4 * 32 + (2 * g - 1 + (((T) < 12 ? (T) : 11) >> 2) < 0 ? 0 : 2 * g - 1 + (((T) < 12 ? (T) : 11) >> 2))) * 512))
    bf16x8 r0 = DG_GLOAD(0), r1 = DG_GLOAD(1), rh = DG_GLOAD(2);
    ATT_WAITBAR();
    *(lds_v8)(dst) = r0; *(lds_v8)(dst + 8192) = r1;
    f32x16 o0 = {}, o1 = {}; float mrun = -1e30f, l = 0.f;
    for (int t = 0; t < 12; ++t) {
        const int v = t >> 2, a = t & 3, w = 2 * g - 1 + v, slot = (t & 3) * 8192;
        const bf16x8 rn = DG_GLOAD(t + 3);
        *(lds_v8)(dst + ((t + 2) & 3) * 8192) = rh;
        ATT_WAITBAR();
        if (w >= 0 && (v == vlo || v == vlo + 1)) {
            bf16x8 KF[4], VF[4];
#pragma unroll
            for (int s = 0; s < 4; ++s) KF[s] = *(lds_v8)(krd + slot + s * 256);
            VF[0] = *(lds_v8)(vrd + slot); VF[1] = *(lds_v8)(vrd + slot + 1024); VF[2] = *(lds_v8)(vrd + slot + 512); VF[3] = *(lds_v8)(vrd + slot + 1024 + 512);
            f32x16 S = {};
#pragma unroll
            for (int s = 0; s < 4; ++s) S = __builtin_amdgcn_mfma_f32_32x32x16_bf16(KF[s], qf[s], S, 0, 0, 0);
            const int dA = tq - 128 * w - 4 * a - 2 * hi, dB = dA - 1;
            float z[16];
#pragma unroll
            for (int i = 0; i < 16; ++i) { const bool ok = (unsigned)(((i >> 3) ? dB : dA) - 16 * (i & 7)) <= 128u; z[i] = ok ? S[i] : -INFINITY; }
            float mx = __builtin_fmaxf(__builtin_fmaxf(__builtin_fmaxf(__builtin_fmaxf(z[0], z[1]), __builtin_fmaxf(z[2], z[3])), __builtin_fmaxf(__builtin_fmaxf(z[4], z[5]), __builtin_fmaxf(z[6], z[7]))),
                                       __builtin_fmaxf(__builtin_fmaxf(__builtin_fmaxf(z[8], z[9]), __builtin_fmaxf(z[10], z[11])), __builtin_fmaxf(__builtin_fmaxf(z[12], z[13]), __builtin_fmaxf(z[14], z[15]))));
            auto rr = __builtin_amdgcn_permlane32_swap(__float_as_uint(mx), __float_as_uint(mx), false, false);
            mx = fmaxf(__uint_as_float(rr[0]), __uint_as_float(rr[1]));
            if (__ballot(mx > mrun) != 0ull) { const float mnew = fmaxf(mrun, mx); const float alpha = __builtin_amdgcn_exp2f(mrun - mnew); mrun = mnew; l *= alpha;
#pragma unroll
                for (int i = 0; i < 16; ++i) { o0[i] *= alpha; o1[i] *= alpha; } }
            float p[16];
#pragma unroll
            for (int i = 0; i < 16; ++i) p[i] = __builtin_amdgcn_exp2f(z[i] - mrun);
            l += (((p[0] + p[1]) + (p[2] + p[3])) + ((p[4] + p[5]) + (p[6] + p[7]))) + (((p[8] + p[9]) + (p[10] + p[11])) + ((p[12] + p[13]) + (p[14] + p[15])));
            const bf16x8 p0 = pack8(p), p1 = pack8(p + 8);
            o0 = __builtin_amdgcn_mfma_f32_32x32x16_bf16(VF[0], p0, o0, 0, 0, 0); o0 = __builtin_amdgcn_mfma_f32_32x32x16_bf16(VF[1], p1, o0, 0, 0, 0);
            o1 = __builtin_amdgcn_mfma_f32_32x32x16_bf16(VF[2], p0, o1, 0, 0, 0); o1 = __builtin_amdgcn_mfma_f32_32x32x16_bf16(VF[3], p1, o1, 0, 0, 0);
        }
        rh = rn;
    }
#undef DG_GLOAD
    auto rr = __builtin_amdgcn_permlane32_swap(__float_as_uint(l), __float_as_uint(l), false, false);
    const float lt = __uint_as_float(rr[0]) + __uint_as_float(rr[1]);
    o_to_lds(scr, o0, o1, 1.0f / lt, r32, hi);
    lds_to_rows(scr, X1 + rowbase * DM + h * HD, 32 * blk, 1, lane);
    if (hi == 0) LSE[(rowbase + tq) * 16 + h] = mrun + __builtin_amdgcn_logf(lt);
}

__device__ __forceinline__ void dil_groups0(const bf16_t* Q, const bf16_t* Kb, const bf16_t* Vt, bf16_t* X1, float* LSE, bool xo, int xcd, int myr, int bid, int G, int tid, LAS unsigned char* lds) {
    const int lane = tid & 63, wave = __builtin_amdgcn_readfirstlane(tid >> 6), r32 = lane & 31, hi = lane >> 5, vlo = wave >> 2;
    LAS unsigned char* scr = lds + SBW_SCR + wave * SCR_BYTES;
    const int part = tid >> 6, rho_s = part & 3;
    LAS unsigned char* wdst = lds + part * 1024 + (tid & 63) * 16;
    const int u_m = (r32 >> 4) & 1, hi_m = (r32 >> 2) & 1, j_m = (r32 & 3) + 4 * ((r32 >> 3) & 1), rho_m = 2 * hi_m + u_m;
    LAS unsigned char* krd = lds + rho_m * 1024 + (hi * 8 + j_m) * 16;
    LAS unsigned char* vrd = lds + 4096 + (2 * hi) * 1024 + r32 * 16;
    const int nit = xo ? 16 : (4096 - bid + G - 1) / G;
    bf16x8 W[12]; u32x4 QR[4];
#define DG_ITEM(I, BH, GR) const int u__##BH = xo ? myr + 32 * (I) : bid + G * (I); const int BH = xo ? xcd * 32 + (u__##BH >> 4) : (u__##BH >> 4), GR = u__##BH & 15
#define DG_PREFETCH(I) do { DG_ITEM(I, bh_, g_); \
        const bf16_t* src_ = ((part < 4) ? Kb : Vt) + (size_t)bh_ * (16 * 32 * 512) + (size_t)rho_s * (32 * 512) + (tid & 63) * 8; \
        _Pragma("unroll") for (int t = 0; t < 12; ++t) { const int w_ = 2 * g_ - 1 + (t >> 2); W[t] = *(const bf16x8*)(src_ + (size_t)((t & 3) * 4 * 32 + (w_ < 0 ? 0 : w_)) * 512); } \
        const bf16_t* qb_ = Q + ((size_t)(bh_ >> 4) * SEQ) * DM + (bh_ & 15) * HD; \
        _Pragma("unroll") for (int k = 0; k < 4; ++k) QR[k] = __builtin_nontemporal_load((const u32x4*)(qb_ + (size_t)((8 * g_ + wave) * 32 + 8 * k + (lane >> 3)) * DM + (lane & 7) * 8)); } while (0)
    if (nit > 0) DG_PREFETCH(0);
    for (int it = 0; it < nit; ++it) {
        DG_ITEM(it, bh, g);
        const int b = bh >> 4, h = bh & 15, blk = 8 * g + wave, tq = 32 * blk + r32;
        const size_t rowbase = (size_t)b * SEQ;
        ATT_WAITBAR();
#pragma unroll
        for (int t = 0; t < 12; ++t) *(lds_v8)(wdst + t * 8192) = W[t];
#pragma unroll
        for (int k = 0; k < 4; ++k) *(LAS u32x4*)(scr + (8 * k + (lane >> 3)) * SCR_PITCH + (lane & 7) * 16) = QR[k];
        ATT_WAITBAR();
        if (it + 1 < nit) DG_PREFETCH(it + 1);
        bf16x8 qf[4];
#pragma unroll
        for (int s = 0; s < 4; ++s) qf[s] = *(LAS bf16x8*)(scr + r32 * SCR_PITCH + (2 * s + hi) * 16);
        f32x16 o0 = {}, o1 = {}; float mrun = -1e30f, l = 0.f;
        for (int t = 4 * vlo; t < 4 * vlo + 8; ++t) {
            const int v = t >> 2, a = t & 3, w = 2 * g - 1 + v, slot = t * 8192;
            if (w < 0) continue;
            bf16x8 KF[4], VF[4];
#pragma unroll
            for (int s = 0; s < 4; ++s) KF[s] = *(lds_v8)(krd + slot + s * 256);
            VF[0] = *(lds_v8)(vrd + slot); VF[1] = *(lds_v8)(vrd + slot + 1024); VF[2] = *(lds_v8)(vrd + slot + 512); VF[3] = *(lds_v8)(vrd + slot + 1024 + 512);
            f32x16 S = {};
#pragma unroll
            for (int s = 0; s < 4; ++s) S = __builtin_amdgcn_mfma_f32_32x32x16_bf16(KF[s], qf[s], S, 0, 0, 0);
            const int dA = tq - 128 * w - 4 * a - 2 * hi, dB = dA - 1;
            float z[16];
#pragma unroll
            for (int i = 0; i < 16; ++i) { const bool ok = (unsigned)(((i >> 3) ? dB : dA) - 16 * (i & 7)) <= 128u; z[i] = ok ? S[i] : -INFINITY; }
            float mx = __builtin_fmaxf(__builtin_fmaxf(__builtin_fmaxf(__builtin_fmaxf(z[0], z[1]), __builtin_fmaxf(z[2], z[3])), __builtin_fmaxf(__builtin_fmaxf(z[4], z[5]), __builtin_fmaxf(z[6], z[7]))),
                                       __builtin_fmaxf(__builtin_fmaxf(__builtin_fmaxf(z[8], z[9]), __builtin_fmaxf(z[10], z[11])), __builtin_fmaxf(__builtin_fmaxf(z[12], z[13]), __builtin_fmaxf(z[14], z[15]))));
            auto rr = __builtin_amdgcn_permlane32_swap(__float_as_uint(mx), __float_as_uint(mx), false, false);
            mx = fmaxf(__uint_as_float(rr[0]), __uint_as_float(rr[1]));
            if (__ballot(mx > mrun) != 0ull) { const float mnew = fmaxf(mrun, mx); const float alpha = __builtin_amdgcn_exp2f(mrun - mnew); mrun = mnew; l *= alpha;
#pragma unroll
                for (int i = 0; i < 16; ++i) { o0[i] *= alpha; o1[i] *= alpha; } }
            float p[16];
#pragma unroll
            for (int i = 0; i < 16; ++i) p[i] = __builtin_amdgcn_exp2f(z[i] - mrun);
            l += (((p[0] + p[1]) + (p[2] + p[3])) + ((p[4] + p[5]) + (p[6] + p[7]))) + (((p[8] + p[9]) + (p[10] + p[11])) + ((p[12] + p[13]) + (p[14] + p[15])));
            const bf16x8 p0 = pack8(p), p1 = pack8(p + 8);
            o0 = __builtin_amdgcn_mfma_f32_32x32x16_bf16(VF[0], p0, o0, 0, 0, 0); o0 = __builtin_amdgcn_mfma_f32_32x32x16_bf16(VF[1], p1, o0, 0, 0, 0);
            o1 = __builtin_amdgcn_mfma_f32_32x32x16_bf16(VF[2], p0, o1, 0, 0, 0); o1 = __builtin_amdgcn_mfma_f32_32x32x16_bf16(VF[3], p1, o1, 0, 0, 0);
        }
        auto rr = __builtin_amdgcn_permlane32_swap(__float_as_uint(l), __float_as_uint(l), false, false);
        const float lt = __uint_as_float(rr[0]) + __uint_as_float(rr[1]);
        o_to_lds(scr, o0, o1, 1.0f / lt, r32, hi);
        lds_to_rows(scr, X1 + rowbase * DM + h * HD, 32 * blk, 1, lane);
        if (hi == 0) LSE[(rowbase + tq) * 16 + h] = mrun + __builtin_amdgcn_logf(lt);
    }
#undef DG_ITEM
#undef DG_PREFETCH
}

#define GAS __attribute__((address_space(1)))
__device__ __forceinline__ unsigned xb_ld(unsigned* p)              { return __hip_atomic_load(p, __ATOMIC_RELAXED, __HIP_MEMORY_SCOPE_AGENT); }
__device__ __forceinline__ unsigned xb_add(unsigned* p, unsigned v) { return __hip_atomic_fetch_add(p, v, __ATOMIC_RELAXED, __HIP_MEMORY_SCOPE_AGENT); }
#define XB_TMO      128
#define XB_XCNT(j)  (256  + 64 * (j))
#define XB_XSUB(j)  (1280 + 64 * (j))
#define XB_XGEN(j)  (2304 + 64 * (j))
#define XB_TOP      3328
#define XB_TOPGEN   3392
#define XCD_BAR_WORDS 3456
#define XB_SPIN_CAP (1u << 18)

__device__ __forceinline__ unsigned xb_xcc_id() { return (unsigned)__builtin_amdgcn_s_getreg((3 << 11) | 20) & 0xFu; }
#define XB_SPIN(cond, bar) do { unsigned _sp = 0; while (cond) { __builtin_amdgcn_s_sleep(1); \
    if ((++_sp & 255u) == 0u) { if (xb_ld(&(bar)[XB_TMO])) break; if (_sp > XB_SPIN_CAP) { atomicAdd(&(bar)[XB_TMO], 1u); break; } } } } while (0)

struct XcdBarrier {
    unsigned* bar; unsigned x;
    volatile LAS unsigned* st;
};

__device__ __forceinline__ XcdBarrier xcd_barrier_post(unsigned* bar, volatile LAS unsigned* st) {
    XcdBarrier b; b.bar = bar; b.x = xb_xcc_id(); b.st = st;
    if (threadIdx.x == 0) st[2] = xb_add(&bar[XB_XCNT(b.x)], 1u);
    return b;
}
__device__ __forceinline__ void xcd_barrier_complete(unsigned* bar, unsigned x, unsigned& nloc, unsigned& nx) {
    const unsigned G = gridDim.x * gridDim.y * gridDim.z;
    unsigned sum, cnt, mine, sp = 0u;
    for (;;) {
        sum = 0u; cnt = 0u; mine = 0u;
#pragma unroll
        for (unsigned j = 0; j < 16; ++j) { const unsigned c = xb_ld(&bar[XB_XCNT(j)]); sum += c; cnt += (c > 0u) ? 1u : 0u; mine = (j == x) ? c : mine; }
        if (sum == G) break;
        __builtin_amdgcn_s_sleep(1);
        if ((++sp & 255u) == 0u) { if (xb_ld(&bar[XB_TMO])) break; if (sp > XB_SPIN_CAP) { atomicAdd(&bar[XB_TMO], 1u); break; } }
    }
    nloc = mine > 0u ? mine : 1u; nx = cnt > 0u ? cnt : 1u;
}

__device__ __forceinline__ void xcd_barrier(const XcdBarrier& b) {
    asm volatile("s_waitcnt vmcnt(0)" ::: "memory");
    __syncthreads();
    if (threadIdx.x == 0) {
        unsigned* bar = b.bar;
        __builtin_amdgcn_s_waitcnt(0);
        unsigned nloc = b.st[0], nx = b.st[1];
        if (nloc == 0u) { xcd_barrier_complete(bar, b.x, nloc, nx); b.st[0] = nloc; b.st[1] = nx; }
        const unsigned old = xb_add(&bar[XB_XSUB(b.x)], 1u);
        const unsigned gen = old / nloc;
        if (old + 1u == (gen + 1u) * nloc) {
            __builtin_amdgcn_fence(__ATOMIC_RELEASE, "agent");
            asm volatile("s_waitcnt vmcnt(0)" ::: "memory");
            const unsigned og = xb_add(&bar[XB_TOP], 1u);
            const unsigned tg = og / nx;
            if (og + 1u == (tg + 1u) * nx) xb_add(&bar[XB_TOPGEN], 1u);
            else XB_SPIN(xb_ld(&bar[XB_TOPGEN]) == tg, bar);
            __builtin_amdgcn_fence(__ATOMIC_ACQUIRE, "agent");
            xb_add(&bar[XB_XGEN(b.x)], 1u);
            asm volatile("s_waitcnt vmcnt(0)" ::: "memory");
        } else {
            XB_SPIN(xb_ld(&bar[XB_XGEN(b.x)]) == gen, bar);
            __builtin_amdgcn_fence(__ATOMIC_ACQUIRE, "agent");
            asm volatile("s_waitcnt vmcnt(0)" ::: "memory");
        }
    }
    __syncthreads();
}

__global__ void __launch_bounds__(512) yoco_fwd(Args a) {
    extern __shared__ __attribute__((aligned(16))) unsigned char lds_raw[];
    LAS unsigned char* lds = (LAS unsigned char*)lds_raw;
    cg::grid_group grid = cg::this_grid();
    if (threadIdx.x < 4) ((volatile LAS unsigned*)(lds + BARW_OFF))[threadIdx.x] = 0u;
    __syncthreads();
    if (blockIdx.x == 0) { unsigned* bz = (unsigned*)(a.ws + WS_BAR); for (int i = threadIdx.x; i < (int)(BAR_BYTES / 4); i += 512) bz[i] = 0u; }
    XcdBarrier xbar; xbar.bar = (unsigned*)(a.ws + WS_BAR); xbar.x = 0; xbar.st = (volatile LAS unsigned*)(lds + BARW_OFF);
    for (int ph = a.ph_lo; ph < a.ph_hi; ++ph) {
        const int L_ = (ph - 1) / 5, sub_ = (ph - 1) % 5; const bool mid = ph > 0 && ph < NPHASE - 1;
        int nrep = 1;
        if ((PROBE == 1 || PROBE == 8) && mid && sub_ == 1 && L_ < 2) nrep = 2;
        if (PROBE == 3 && mid && sub_ == 3) nrep = 2;
        if (PROBE == 4 && mid && sub_ == 0) nrep = 2;
        if (PROBE == 5 && ph == 3) nrep = 2;
        if ((PROBE == 13 || PROBE == 16) && ph == 1) nrep = 2;
        if (PROBE == 14 && ph == 11) nrep = 2;
        if (PROBE == 15 && ph == 16) nrep = 2;
        if (PROBE == 6 && ph == 0) nrep = 2;
        for (int rep = 0; rep < nrep; ++rep) {
        int tid = threadIdx.x; asm volatile("" : "+v"(tid));
        int bid = blockIdx.x, G = gridDim.x; asm volatile("" : "+s"(bid), "+s"(G));
        const int lane = tid & 63, wave = __builtin_amdgcn_readfirstlane(tid >> 6), gw = bid * 8 + wave, ngw = G * 8;
        ArgsP ap = (ArgsP)__builtin_amdgcn_kernarg_segment_ptr(); asm volatile("" : "+s"(ap));
        unsigned char* ws = ap->ws;
        float* ssqA = (float*)(ws + WS_SSQ); float* ssqB = ssqA; const float* rope = (const float*)(ws + WS_ROPE);
        bf16_t* hb = (bf16_t*)(ws + WS_HB); bf16_t* qo = (bf16_t*)(ws + WS_QO); bf16_t* kb = (bf16_t*)(ws + WS_K); bf16_t* vt = (bf16_t*)(ws + WS_VT); bf16_t* act = (bf16_t*)(ws + WS_ACT);
        bf16_t* odst = (rep + 1 < nrep) ? act : qo;
        if (PROBE == 7 && rep == 0 && ph > 0) grid.sync();
        if (ph == 0) prologue(ap, lds, gw, ngw, wave, lane);
        else if (ph == NPHASE - 1) final_norm(ap, gw, ngw, lane);
        else {
            const int L = (ph - 1) / 5, sub = (ph - 1) % 5;
            if (sub == 0) {
                const bf16_t* W = (L < 2) ? (const bf16_t*)(ws + WS_WQKV_A + L * SZ_WQKV) : (L == 2 ? (const bf16_t*)(ws + WS_WB2) : (const bf16_t*)(ws + WS_WB3));
                const int N = (L == 3) ? 1024 : 3072;
                pg8::Gemm g{hb, W, MTOK, N, DM}; pg8::StaticOrder S; S.init(MTOK, N, G, bid);
                if (L < 2) { pg8::EpiQKV<0> E{qo, kb, vt, ssqB, rope}; pg8::gemm_phase<pg8::EpiQKV<0>, pg8::StaticOrder, true, true>(lds, g, S, E); }
                else { pg8::EpiQKV<1> E{qo, kb, vt, ssqB, rope}; pg8::gemm_phase<pg8::EpiQKV<1>, pg8::StaticOrder, true, true>(lds, g, S, E); }
            } else if (sub == 1) {
                if (L < 2) {
                    sb_groups(qo, kb, vt, odst, bid, G, tid, lds);
                } else {
                    bf16_t* x1 = act; float* lse = (float*)(ws + WS_ACT + 128 * MiB);
                    bool xo = (G == 256); { unsigned* bw = (unsigned*)(ws + WS_BAR);
#pragma unroll
                        for (int j = 0; j < 16; ++j) xo = xo && (xb_ld(&bw[XB_XCNT(j)]) == (j < 8 ? 32u : 0u)); }
                    const int myx = (int)xb_xcc_id(), myr = (int)((volatile LAS unsigned*)(lds + BARW_OFF))[2];
                    const int wpx = xo ? 256 : ngw, vw = xo ? myr * 8 + wave : gw, xcd = xo ? myx : 0, nun = xo ? 4096 : 32768;
                    dil_groups0(qo, kb, vt, x1, lse, xo, xcd, myr, bid, G, tid, lds);
                    if (PROBE == 9 || PROBE == 10) { int t3 = threadIdx.x; asm volatile("" : "+v"(t3)); const int lane3 = t3 & 63;
                        for (int u = vw; u < nun; u += wpx) { const int bh = xcd * 32 + (u >> 7), rem = u & 127; dil_unit<0>(qo, kb, vt, qo, x1 + 136 * MiB / 2, lse + 66 * MiB, bh, 0, rem, lane3, lds + SCR_OFF + wave * SCR_BYTES, PROBE == 9 ? 64 : 2); } }
                    if (PROBE == 12) { int t3 = threadIdx.x; asm volatile("" : "+v"(t3));
                        if (xo) { for (int u = myr; u < 512; u += 32) dil_group0(qo, kb, vt, x1 + 136 * MiB / 2, lse + 66 * MiB, xcd * 32 + (u >> 4), u & 15, t3, lds); }
                        else { for (int u = bid; u < 4096; u += G) dil_group0(qo, kb, vt, x1 + 136 * MiB / 2, lse + 66 * MiB, u >> 4, u & 15, t3, lds); } }
                    xcd_barrier(xbar);
                    if (PROBE == 11) { int t4 = threadIdx.x; asm volatile("" : "+v"(t4)); const int lane4 = t4 & 63;
                        for (int u = vw; u < nun; u += wpx) { const int bh = xcd * 32 + (u >> 7), rem = u & 127; dil_unit<1>(qo, kb, vt, x1 + 136 * MiB / 2, x1, lse, bh, rem & 15, rem >> 4, lane4, lds + SCR_OFF + wave * SCR_BYTES); } }
                    { int t2 = threadIdx.x; asm volatile("" : "+v"(t2)); const int lane2 = t2 & 63;
                    for (int u = vw; u < nun; u += wpx) { const int bh = xcd * 32 + (u >> 7), rem = u & 127; dil_unit<1>(qo, kb, vt, qo, x1, lse, bh, rem & 15, rem >> 4, lane2, lds + SCR_OFF + wave * SCR_BYTES); } }
                }
            } else if (sub == 2) {
                const bf16_t* W = (L < 2) ? (const bf16_t*)(ws + WS_WO_A + L * SZ_WSQ) : (const bf16_t*)(ws + WS_WO_B + (L - 2) * SZ_WSQ);
                pg8::Gemm g{qo, W, MTOK, DM, DM}; pg8::StaticOrder S; S.init(MTOK, DM, G, bid);
                pg8::EpiRes E{hb, ssqA};
                pg8::gemm_phase<pg8::EpiRes, pg8::StaticOrder, true, true>(lds, g, S, E);
            } else if (sub == 3) {
                pg8::Gemm g{hb, (const bf16_t*)(ws + WS_WGU + L * SZ_WGU), MTOK, 2 * DFF, DM}; pg8::StaticOrder S; S.init(MTOK, 2 * DFF, G, bid);
                pg8::EpiSwiGLU E{act, ssqA};
                pg8::gemm_phase<pg8::EpiSwiGLU, pg8::StaticOrder, true, true>(lds, g, S, E);
            } else {
                pg8::Gemm g{act, (const bf16_t*)(ws + WS_WDN + L * SZ_WDN), MTOK, DM, DFF}; pg8::StaticOrder S; S.init(MTOK, DM, G, bid);
                pg8::EpiRes E{hb, ssqB};
                pg8::gemm_phase<pg8::EpiRes, pg8::StaticOrder, true, true>(lds, g, S, E);
            }
        }
        }
        if (ph + 1 < a.ph_hi) { if (ph == a.ph_lo) { grid.sync(); xbar = xcd_barrier_post((unsigned*)(a.ws + WS_BAR), (volatile LAS unsigned*)(lds + BARW_OFF)); } else xcd_barrier(xbar); }
    }
}

#ifndef N_LAUNCHES
#define N_LAUNCHES 1
#endif
extern "C" void kernel_launch(void* const* d_in, const int* in_sizes, int n_in, void* d_out, int out_size, void* d_ws, size_t ws_size, hipStream_t stream) {
    static int grid = 0;
    if (grid == 0) {
        if (n_in != 13 || in_sizes[0] != MTOK * DM || out_size != MTOK * DM || ws_size < WS_END) { fprintf(stderr, "kernel_launch: unexpected shapes / workspace (n_in %d, ws %zu)\n", n_in, ws_size); grid = -1; return; }
        int dev = 0, cus = 0, per_cu = 0;
        (void)hipGetDevice(&dev); (void)hipDeviceGetAttribute(&cus, hipDeviceAttributeMultiprocessorCount, dev);
        if (hipFuncSetAttribute((const void*)yoco_fwd, hipFuncAttributeMaxDynamicSharedMemorySize, LDS_BYTES) != hipSuccess) { fprintf(stderr, "kernel_launch: hipFuncSetAttribute failed\n"); grid = -1; return; }
        if (hipOccupancyMaxActiveBlocksPerMultiprocessor(&per_cu, (const void*)yoco_fwd, 512, LDS_BYTES) != hipSuccess || per_cu < 1) per_cu = 1;
        (void)hipGetLastError();
        grid = cus * per_cu;
        if (grid > 256) grid = 256;
    }
    if (grid < 0) return;
    Args a{};
    for (int i = 0; i < 13; ++i) a.in[i] = (const float*)d_in[i];
    a.out = (float*)d_out; a.ws = (unsigned char*)d_ws;
    if (N_LAUNCHES == 1) {
        a.ph_lo = 0; a.ph_hi = NPHASE;
        void* kargs[] = {&a};
        hipError_t e = hipLaunchCooperativeKernel((const void*)yoco_fwd, dim3(grid), dim3(512), kargs, LDS_BYTES, stream);
        if (e != hipSuccess) fprintf(stderr, "cooperative launch failed: %s (grid %d)\n", hipGetErrorString(e), grid);
    } else {
        for (int ph = 0; ph < NPHASE; ++ph) { a.ph_lo = ph; a.ph_hi = ph + 1; hipLaunchKernelGGL(yoco_fwd, dim3(grid), dim3(512), LDS_BYTES, stream, a); }
    }
}
```

```cpp
#include <hip/hip_runtime.h>
#include <hip/hip_cooperative_groups.h>
#include <cstdio>
#include <cstdint>
namespace cg = cooperative_groups;
namespace pg8 {
#define PG8_LAS __attribute__((address_space(3)))
typedef unsigned short bf16_t;
typedef short bf16x8 __attribute__((ext_vector_type(8)));
typedef float f32x4 __attribute__((ext_vector_type(4)));
typedef unsigned u32x4 __attribute__((ext_vector_type(4)));
constexpr int BM = 256, BK = 64, HALF = 128, HTB = HALF * BK * 2  , STAGE_BYTES = 8 * HTB, NXCD = 8, WGM = 8;

__host__ __device__ __forceinline__ int lds_byte(int r, int c) { const int st = (r >> 4) * 2 + (c >> 5), rr = r & 15, cc = c & 31, ob = rr * 64 + cc * 2; return st * 1024 + (ob ^ (((ob >> 9) & 1) << 5)); }
__host__ __device__ __forceinline__ void stage_rc(int b, int& R, int& C) { const int st = b / 1024, sb = b % 1024, swz = sb ^ (((sb >> 9) & 1) << 5); R = (st >> 1) * 16 + swz / 64; C = (st & 1) * 32 + (swz % 64) / 2; }
__host__ __device__ __forceinline__ int perm32(int rho) { const int n = rho >> 4, i = rho & 15; return 8 * (i >> 2) + 4 * n + (i & 3); }

struct Unit { int pm, pn; };
struct Gemm { const bf16_t* A; const bf16_t* Bt; int M, N, K; };

struct StaticOrder {
    int nM, nN, nwg, G, c;
    __host__ __device__ void init(int M, int N, int G_, int c_) { nM = M / BM; nN = N / BM; nwg = nM * nN; G = G_; c = c_; }
    __host__ __device__ bool next(int i, Unit& u) const {
        const long L = (long)i * G + c; if (L >= nwg) return false;
        int wgid = (int)L; { const int q = nwg / NXCD, r = nwg % NXCD, xcd = wgid % NXCD, off = wgid / NXCD; wgid = (xcd < r ? xcd * (q + 1) : r * (q + 1) + (xcd - r) * q) + off; }
        const int nig = WGM * nN, gid = wgid / nig, fm = gid * WGM, gsz = (nM - fm) < WGM ? (nM - fm) : WGM;
        u.pm = fm + ((wgid % nig) % gsz); u.pn = (wgid % nig) / gsz; return true;
    }
    __device__ __forceinline__ void a_ready(const Unit&) const {}
    __device__ __forceinline__ void done(const Unit&) const {}
};

typedef unsigned u32x2 __attribute__((ext_vector_type(2)));
__device__ __forceinline__ unsigned cvt_pk_bf16(float lo, float hi) { unsigned r; asm volatile("v_cvt_pk_bf16_f32 %0, %1, %2" : "=v"(r) : "v"(lo), "v"(hi)); return r; }
constexpr float NORM_EPS = 1e-6f;
constexpr float QSCALE = 0.125f * 1.4426950408889634f;
__device__ __forceinline__ float row_rstd(const float* ssq, size_t row) {
    const f32x4* p = (const f32x4*)(ssq + row * 16); const f32x4 a = p[0], b = p[1], c = p[2], d = p[3];
    const float t = ((a[0] + a[1]) + (a[2] + a[3])) + ((b[0] + b[1]) + (b[2] + b[3])) + ((c[0] + c[1]) + (c[2] + c[3])) + ((d[0] + d[1]) + (d[2] + d[3]));
    return __builtin_amdgcn_rsqf(t * (1.0f / 1024.0f) + NORM_EPS);
}
__device__ __forceinline__ float row_ssq4(const float* ssq, size_t row, int fq) { const f32x4 a = ((const f32x4*)(ssq + row * 16))[fq]; return (a[0] + a[1]) + (a[2] + a[3]); }
__device__ __forceinline__ float rstd_fin(float t) { t += __shfl_xor(t, 16); t += __shfl_xor(t, 32); return __builtin_amdgcn_rsqf(t * (1.0f / 1024.0f) + NORM_EPS); }
template <int VMODE> struct EpiQKV {
    static constexpr bool PERM = true, AFTER_DRAIN = false, PERM_A = (VMODE == 0); static constexpr int vmode = VMODE, rope_on = VMODE, RM = PERM_A ? 1 : 16, RF = PERM_A ? 4 : 1;
    bf16_t* Q; bf16_t* Kb; bf16_t* Vt; const float* ssq; const float* rope;
    __device__ __forceinline__ void operator()(const f32x4 (&acc)[2][2][4][2], const Unit& u, int wr, int wc, int fr, int fq) const {
        asm volatile("" : "+v"(fr), "+v"(fq));
        const int type = u.pn >> 2, head = (u.pn & 3) * 4 + wc;
        const int b = u.pm >> 4, s0 = (u.pm & 15) * 256 + wr * 64 + RF * fr;
        const size_t row0 = (size_t)u.pm * 256 + wr * 64 + RF * fr;
        if (type < 2) {
            bf16_t* base = (type == 0) ? Q : Kb; const float sc = (type == 0) ? QSCALE : 1.0f;
            float rs[8];
#pragma unroll
            for (int t = 0; t < 8; ++t) rs[t] = row_ssq4(ssq, row0 + (t >> 2) * 128 + (t & 3) * RM, fq);
#pragma unroll
            for (int t = 0; t < 8; ++t) rs[t] = rstd_fin(rs[t]) * sc;
            f32x4 cs[2][2], sn[2][2];
            if (rope_on) { const float* rp = rope + (size_t)s0 * 64 + 8 * fq;
#pragma unroll
                for (int n = 0; n < 2; ++n) { cs[0][n] = *(const f32x4*)(rp + 4 * n); sn[0][n] = *(const f32x4*)(rp + 32 + 4 * n); } }
#pragma unroll
            for (int t = 0; t < 8; ++t) {
                const int ai = t >> 2, m = t & 3, cur = t & 1, nxt = cur ^ 1;
                const size_t row = row0 + ai * 128 + m * RM; const int s = s0 + ai * 128 + m * RM; const float f = rs[t];
                if (rope_on && t < 7) { const float* rp = rope + (size_t)(s0 + ((t + 1) >> 2) * 128 + ((t + 1) & 3) * RM) * 64 + 8 * fq;
#pragma unroll
                    for (int n = 0; n < 2; ++n) { cs[nxt][n] = *(const f32x4*)(rp + 4 * n); sn[nxt][n] = *(const f32x4*)(rp + 32 + 4 * n); } }
                f32x4 lo[2], hi[2];
#pragma unroll
                for (int n = 0; n < 2; ++n) { lo[n] = acc[ai][0][m][n] * f; hi[n] = acc[ai][1][m][n] * f; }
                if (rope_on) {
#pragma unroll
                    for (int n = 0; n < 2; ++n) { const f32x4 a1 = lo[n], a2 = hi[n]; lo[n] = a1 * cs[cur][n] - a2 * sn[cur][n]; hi[n] = a2 * cs[cur][n] + a1 * sn[cur][n]; } }
                bf16_t* dst; int hoff;
                if (type == 1 && vmode == 1) { dst = base + ((size_t)((b * 16 + head) * 16 + fr) * 32 + (u.pm & 15) * 2 + ai) * 512 + (fq * 8 + 4 * wr + m) * 8; hoff = 256; }
                else if (type == 1) {
                    const int kk = s & 31, mrow = 8 * ((kk >> 2) & 3) + 4 * (kk >> 4) + (kk & 3);
                    dst = base + ((size_t)(b * 16 + head) * 128 + (s >> 5)) * 2048 + (fq >> 1) * 512 + ((fq & 1) * 32 + mrow) * 8; hoff = 1024; }
                else { dst = base + row * 1024 + head * 64 + 8 * fq; hoff = 32; }
                u32x4 w; w.x = cvt_pk_bf16(lo[0][0], lo[0][1]); w.y = cvt_pk_bf16(lo[0][2], lo[0][3]); w.z = cvt_pk_bf16(lo[1][0], lo[1][1]); w.w = cvt_pk_bf16(lo[1][2], lo[1][3]);
                *(u32x4*)dst = w;
                w.x = cvt_pk_bf16(hi[0][0], hi[0][1]); w.y = cvt_pk_bf16(hi[0][2], hi[0][3]); w.z = cvt_pk_bf16(hi[1][0], hi[1][1]); w.w = cvt_pk_bf16(hi[1][2], hi[1][3]);
                *(u32x4*)(dst + hoff) = w;
                if (rope_on) asm volatile("" ::: "memory");
            }
        } else {
            bf16_t* vb = Vt + ((size_t)(b * 16 + head) * 64) * 4096;
            float rstd[2][4];
#pragma unroll
            for (int ai = 0; ai < 2; ++ai)
#pragma unroll
                for (int m = 0; m < 4; ++m) rstd[ai][m] = row_ssq4(ssq, row0 + ai * 128 + m * RM, fq);
#pragma unroll
            for (int ai = 0; ai < 2; ++ai)
#pragma unroll
                for (int m = 0; m < 4; ++m) rstd[ai][m] = rstd_fin(rstd[ai][m]);
#pragma unroll
            for (int bj = 0; bj < 2; ++bj)
#pragma unroll
                for (int n = 0; n < 2; ++n)
#pragma unroll
                    for (int i = 0; i < 4; ++i) {
#pragma unroll
                        for (int ai = 0; ai < 2; ++ai) {
                            const float v0 = acc[ai][bj][0][n][i] * rstd[ai][0], v1 = acc[ai][bj][1][n][i] * rstd[ai][1], v2 = acc[ai][bj][2][n][i] * rstd[ai][2], v3 = acc[ai][bj][3][n][i] * rstd[ai][3];
                            const unsigned p01 = cvt_pk_bf16(v0, v1), p23 = cvt_pk_bf16(v2, v3);
                            if (vmode == 0) {
                                u32x2 w; w.x = p01; w.y = p23;
                                *(u32x2*)(vb + (size_t)((u.pm & 15) * 8 + 4 * ai + 2 * wr + (fr >> 3)) * 2048 + ((bj * 2 + ((fr >> 1) & 1)) * 64 + ((fr >> 2) & 1) * 32 + 8 * fq + 4 * n + i) * 8 + 4 * (fr & 1)) = w; }
                            else { u32x2 w; w.x = p01; w.y = p23;
                                *(u32x2*)(vb + ((size_t)fr * 32 + (u.pm & 15) * 2 + ai) * 512 + (32 * bj + 8 * fq + 4 * n + i) * 8 + wr * 4) = w; }
                        }
                    }
        }
    }
};
struct EpiRes {
    static constexpr bool PERM = true, AFTER_DRAIN = false, PERM_A = false;
    bf16_t* hb; float* ssq;
    __device__ __forceinline__ void operator()(const f32x4 (&acc)[2][2][4][2], const Unit& u, int wr, int wc, int fr, int fq) const {
        asm volatile("" : "+v"(fr), "+v"(fq));
        const int c0 = u.pn * 256 + wc * 32 + 8 * fq; const size_t row0 = (size_t)u.pm * 256 + wr * 64 + fr;
        u32x4 old[2][2];
#pragma unroll
        for (int bj = 0; bj < 2; ++bj) old[0][bj] = *(const u32x4*)(hb + row0 * 1024 + c0 + bj * 128);
#pragma unroll
        for (int t = 0; t < 8; ++t) {
            const int ai = t >> 2, m = t & 3, cur = t & 1, nxt = cur ^ 1;
            const size_t row = row0 + ai * 128 + m * 16; float ss = 0.f;
            if (t < 7) { const size_t rn = row0 + ((t + 1) >> 2) * 128 + ((t + 1) & 3) * 16;
#pragma unroll
                for (int bj = 0; bj < 2; ++bj) old[nxt][bj] = *(const u32x4*)(hb + rn * 1024 + c0 + bj * 128); }
#pragma unroll
            for (int bj = 0; bj < 2; ++bj) { const size_t off = row * 1024 + c0 + bj * 128; const u32x4 o = old[cur][bj];
                f32x4 h0 = acc[ai][bj][m][0], h1 = acc[ai][bj][m][1];
                h0[0] += __uint_as_float(o.x << 16); h0[1] += __uint_as_float(o.x & 0xffff0000u); h0[2] += __uint_as_float(o.y << 16); h0[3] += __uint_as_float(o.y & 0xffff0000u);
                h1[0] += __uint_as_float(o.z << 16); h1[1] += __uint_as_float(o.z & 0xffff0000u); h1[2] += __uint_as_float(o.w << 16); h1[3] += __uint_as_float(o.w & 0xffff0000u);
                u32x4 w; w.x = cvt_pk_bf16(h0[0], h0[1]); w.y = cvt_pk_bf16(h0[2], h0[3]); w.z = cvt_pk_bf16(h1[0], h1[1]); w.w = cvt_pk_bf16(h1[2], h1[3]); *(u32x4*)(hb + off) = w;
                ss += ((h0[0] * h0[0] + h0[1] * h0[1]) + (h0[2] * h0[2] + h0[3] * h0[3])) + ((h1[0] * h1[0] + h1[1] * h1[1]) + (h1[2] * h1[2] + h1[3] * h1[3])); }
            ss += __shfl_xor(ss, 16); ss += __shfl_xor(ss, 32);
            if (fq == 0) ssq[row * 16 + u.pn * 4 + wc] = ss;
            asm volatile("" ::: "memory");
        }
    }
};
struct EpiSwiGLU {
    static constexpr bool PERM = true, AFTER_DRAIN = false, PERM_A = false;
    bf16_t* act; const float* ssq;
    __device__ __forceinline__ void operator()(const f32x4 (&acc)[2][2][4][2], const Unit& u, int wr, int wc, int fr, int fq) const {
        asm volatile("" : "+v"(fr), "+v"(fq));
        const int col0 = u.pn * 128 + wc * 32 + 8 * fq; const size_t row0 = (size_t)u.pm * 256 + wr * 64 + fr;
        float rsv[8];
#pragma unroll
        for (int t = 0; t < 8; ++t) rsv[t] = row_ssq4(ssq, row0 + (t >> 2) * 128 + (t & 3) * 16, fq);
#pragma unroll
        for (int t = 0; t < 8; ++t) rsv[t] = rstd_fin(rsv[t]);
#pragma unroll
        for (int ai = 0; ai < 2; ++ai)
#pragma unroll
            for (int m = 0; m < 4; ++m) {
                const size_t row = row0 + ai * 128 + m * 16; const float rs = rsv[ai * 4 + m];
                float o[8];
#pragma unroll
                for (int n = 0; n < 2; ++n)
#pragma unroll
                    for (int i = 0; i < 4; ++i) { const float g = acc[ai][0][m][n][i] * rs, up = acc[ai][1][m][n][i] * rs;
                        const float sg = __builtin_amdgcn_rcpf(1.0f + __builtin_amdgcn_exp2f(-1.4426950408889634f * g)); o[4 * n + i] = g * sg * up; }
                u32x4 w; w.x = cvt_pk_bf16(o[0], o[1]); w.y = cvt_pk_bf16(o[2], o[3]); w.z = cvt_pk_bf16(o[4], o[5]); w.w = cvt_pk_bf16(o[6], o[7]);
                __builtin_nontemporal_store(w, (u32x4*)(act + row * 2816 + col0));
            }
    }
};

template <class Epi, class Sched, bool ALIGN_EPI = false, bool SP2 = false>
__device__ __forceinline__ void gemm_phase(PG8_LAS unsigned char* lds, const Gemm g, const Sched& S, const Epi& E) {
    int tid_l = threadIdx.x; asm volatile("" : "+v"(tid_l)); const int tid = tid_l, wid = __builtin_amdgcn_readfirstlane(tid >> 6), lane = tid & 63, wr = wid >> 2, wc = wid & 3, fr = lane & 15, fq = lane >> 4;
    const int K = g.K, nt = K / BK;
    unsigned voffA[2], voffB[2];
#pragma unroll
    for (int i = 0; i < 2; ++i) { int R, C; stage_rc(tid * 16 + i * 8192, R, C); const int Rb = Epi::PERM ? ((R & ~31) + perm32(R & 31)) : R;
        const int Ra = Epi::PERM_A ? ((R & ~63) + 4 * (R & 15) + ((R >> 4) & 3)) : R;
        voffA[i] = (unsigned)(Ra * K + C) * 2u; voffB[i] = (unsigned)(Rb * K + C) * 2u; }
    const size_t kstep = (size_t)(BK * 2);
    const size_t hstep = (size_t)HALF * K * 2;
    const size_t tstep = 2 * hstep;
    const unsigned ldsw = (unsigned)wid * 1024u;
    const int aoff = lds_byte(wr * 64 + fr, fq * 8), boff = lds_byte(wc * 32 + fr, fq * 8);
#define PG8_SA(b, h) (((b) * 2 + (h)) * HTB)
#define PG8_SB(b, h) ((4 + (b) * 2 + (h)) * HTB)
#define PG8_STAGE(bufoff, gbase, voff) do { _Pragma("unroll") for (int _i = 0; _i < 2; ++_i) \
        __builtin_amdgcn_global_load_lds((const unsigned*)((const char*)(gbase) + (voff)[_i]), (PG8_LAS unsigned*)(lds + (bufoff) + ldsw + _i * 8192), 16, 0, 0); } while (0)
#define PG8_LDA(dst, b, h) do { _Pragma("unroll") for (int m = 0; m < 4; ++m) _Pragma("unroll") for (int k = 0; k < 2; ++k) dst[m][k] = *(const PG8_LAS bf16x8*)(lds + PG8_SA(b, h) + aoff + m * 2048 + k * 1024); } while (0)
#define PG8_LDB(dst, b, h) do { _Pragma("unroll") for (int n = 0; n < 2; ++n) _Pragma("unroll") for (int k = 0; k < 2; ++k) dst[n][k] = *(const PG8_LAS bf16x8*)(lds + PG8_SB(b, h) + boff + n * 2048 + k * 1024); } while (0)
#define PG8_MMA(ai, bj, At, Bt) do { __builtin_amdgcn_s_setprio(1); _Pragma("unroll") for (int m = 0; m < 4; ++m) _Pragma("unroll") for (int n = 0; n < 2; ++n) _Pragma("unroll") for (int k = 0; k < 2; ++k) \
        acc[ai][bj][m][n] = __builtin_amdgcn_mfma_f32_16x16x32_bf16(Bt[n][k], At[m][k], acc[ai][bj][m][n], 0, 0, 0); __builtin_amdgcn_s_setprio(0); } while (0)
#define PG8_WAIT_V(n) asm volatile("s_waitcnt vmcnt(" #n ")" ::: "memory")
#define PG8_WAIT_L(n) asm volatile("s_waitcnt lgkmcnt(" #n ")" ::: "memory")
#define PG8_BAR __builtin_amdgcn_s_barrier()
#define PG8_SCHED __builtin_amdgcn_sched_barrier(0)
    Unit cur, nxt; int ui = 0;
    if (!S.next(0, cur)) return;
    f32x4 acc[2][2][4][2];
#pragma unroll
    for (int a = 0; a < 2; ++a)
#pragma unroll
        for (int b = 0; b < 2; ++b)
#pragma unroll
            for (int m = 0; m < 4; ++m)
#pragma unroll
                for (int n = 0; n < 2; ++n) acc[a][b][m][n] = (f32x4){0.f, 0.f, 0.f, 0.f};
    bf16x8 At[4][2], B0[2][2], B1[2][2];
    const char* cA = (const char*)g.A + (size_t)cur.pm * tstep; const char* cB = (const char*)g.Bt + (size_t)cur.pn * tstep;
    S.a_ready(cur);
    if constexpr (SP2) {
        PG8_STAGE(PG8_SB(0, 0), cB, voffB); PG8_STAGE(PG8_SB(0, 1), cB + hstep, voffB); PG8_STAGE(PG8_SA(0, 0), cA, voffA); PG8_STAGE(PG8_SA(0, 1), cA + hstep, voffA);
        if (wr == 1) PG8_BAR;
        PG8_WAIT_V(2); PG8_BAR;
        PG8_STAGE(PG8_SB(1, 0), cB + kstep, voffB); PG8_STAGE(PG8_SA(1, 0), cA + kstep, voffA); PG8_STAGE(PG8_SB(1, 1), cB + hstep + kstep, voffB);
        PG8_WAIT_V(6); PG8_BAR;
    } else {
        PG8_STAGE(PG8_SB(0, 0), cB, voffB); PG8_STAGE(PG8_SA(0, 0), cA, voffA); PG8_STAGE(PG8_SB(0, 1), cB + hstep, voffB); PG8_STAGE(PG8_SA(0, 1), cA + hstep, voffA);
        if (wr == 1) PG8_BAR;
        PG8_WAIT_V(4); PG8_BAR;
        PG8_STAGE(PG8_SB(1, 0), cB + kstep, voffB); PG8_STAGE(PG8_SA(1, 0), cA + kstep, voffA); PG8_STAGE(PG8_SB(1, 1), cB + hstep + kstep, voffB);
        PG8_WAIT_V(6); PG8_BAR;
    }
    for (;;) {
        const bool has_next = S.next(ui + 1, nxt);
        const char* nA = has_next ? (const char*)g.A + (size_t)nxt.pm * tstep : cA; const char* nB = has_next ? (const char*)g.Bt + (size_t)nxt.pn * tstep : cB;
        for (int t = 0; t < nt; t += 2) {
            const bool last = (t == nt - 2);
            const char* a1 = cA + (size_t)(t + 1) * kstep;
            const char* a2 = last ? nA : cA + (size_t)(t + 2) * kstep; const char* b2 = last ? nB : cB + (size_t)(t + 2) * kstep;
            const char* a3 = a2 + kstep; const char* b3 = b2 + kstep;
            if (last && has_next) S.a_ready(nxt);
            if constexpr (SP2) {
            PG8_LDB(B0, 0, 0); PG8_LDB(B1, 0, 1); PG8_SCHED; PG8_LDA(At, 0, 0); PG8_STAGE(PG8_SA(1, 1), a1 + hstep, voffA);
            PG8_WAIT_V(8); PG8_WAIT_L(0); PG8_BAR; PG8_MMA(0, 0, At, B0); PG8_MMA(0, 1, At, B1); PG8_BAR; PG8_SCHED;
            PG8_LDA(At, 0, 1); PG8_STAGE(PG8_SB(0, 0), b2, voffB); PG8_STAGE(PG8_SB(0, 1), b2 + hstep, voffB); PG8_STAGE(PG8_SA(0, 0), a2, voffA);
            PG8_WAIT_V(8); PG8_WAIT_L(0); PG8_BAR; PG8_MMA(1, 0, At, B0); PG8_MMA(1, 1, At, B1); PG8_BAR; PG8_SCHED;
            PG8_LDB(B0, 1, 0); PG8_LDB(B1, 1, 1); PG8_SCHED; PG8_LDA(At, 1, 0); PG8_STAGE(PG8_SA(0, 1), a2 + hstep, voffA);
            PG8_WAIT_V(8); PG8_WAIT_L(0); PG8_BAR; PG8_MMA(0, 0, At, B0); PG8_MMA(0, 1, At, B1); PG8_BAR; PG8_SCHED;
            PG8_LDA(At, 1, 1); PG8_STAGE(PG8_SB(1, 0), b3, voffB); PG8_STAGE(PG8_SB(1, 1), b3 + hstep, voffB); PG8_STAGE(PG8_SA(1, 0), a3, voffA);
            PG8_WAIT_V(8); PG8_WAIT_L(0); PG8_BAR; PG8_MMA(1, 0, At, B0); PG8_MMA(1, 1, At, B1); PG8_BAR; PG8_SCHED;
            } else {
            PG8_LDB(B0, 0, 0); PG8_SCHED; PG8_LDA(At, 0, 0); PG8_STAGE(PG8_SA(1, 1), a1 + hstep, voffA);
            PG8_WAIT_L(8); PG8_BAR; PG8_WAIT_L(0); PG8_MMA(0, 0, At, B0); PG8_BAR; PG8_SCHED;
            PG8_LDB(B1, 0, 1); PG8_STAGE(PG8_SB(0, 0), b2, voffB);
            PG8_BAR; PG8_WAIT_L(0); PG8_MMA(0, 1, At, B1); PG8_BAR;
            PG8_LDA(At, 0, 1); PG8_STAGE(PG8_SA(0, 0), a2, voffA);
            PG8_BAR; PG8_WAIT_L(0); PG8_MMA(1, 0, At, B0); PG8_BAR; PG8_SCHED;
            PG8_STAGE(PG8_SB(0, 1), b2 + hstep, voffB);
            PG8_WAIT_V(6); PG8_BAR; PG8_MMA(1, 1, At, B1); PG8_BAR;
            PG8_LDB(B0, 1, 0); PG8_SCHED; PG8_LDA(At, 1, 0); PG8_STAGE(PG8_SA(0, 1), a2 + hstep, voffA);
            PG8_WAIT_L(8); PG8_BAR; PG8_WAIT_L(0); PG8_MMA(0, 0, At, B0); PG8_BAR; PG8_SCHED;
            PG8_LDB(B1, 1, 1); PG8_STAGE(PG8_SB(1, 0), b3, voffB);
            PG8_BAR; PG8_WAIT_L(0); PG8_MMA(0, 1, At, B1); PG8_BAR;
            PG8_LDA(At, 1, 1); PG8_STAGE(PG8_SA(1, 0), a3, voffA);
            PG8_BAR; PG8_WAIT_L(0); PG8_MMA(1, 0, At, B0); PG8_BAR; PG8_SCHED;
            PG8_STAGE(PG8_SB(1, 1), b3 + hstep, voffB);
            PG8_WAIT_V(6); PG8_BAR; PG8_MMA(1, 1, At, B1); PG8_BAR;
            }
        }
        if constexpr (ALIGN_EPI) { if (wr == 0) PG8_BAR; }
        if constexpr (!Epi::AFTER_DRAIN) { E(acc, cur, wr, wc, fr, fq); S.done(cur); }
        if (!has_next) break;
#pragma unroll
        for (int a = 0; a < 2; ++a)
#pragma unroll
            for (int b = 0; b < 2; ++b)
#pragma unroll
                for (int m = 0; m < 4; ++m)
#pragma unroll
                    for (int n = 0; n < 2; ++n) acc[a][b][m][n] = (f32x4){0.f, 0.f, 0.f, 0.f};
        cur = nxt; cA = nA; cB = nB; ++ui;
        if constexpr (ALIGN_EPI) { if (wr == 1) PG8_BAR; }
    }
    PG8_WAIT_V(0);
    if constexpr (!ALIGN_EPI) { if (wr == 0) PG8_BAR; }
    PG8_BAR;
    if constexpr (Epi::AFTER_DRAIN) { E.fused(acc, cur, wr, wc, fr, fq, lds, wid, lane); S.done(cur); }
#undef PG8_SA
#undef PG8_SB
#undef PG8_STAGE
#undef PG8_LDA
#undef PG8_LDB
#undef PG8_MMA
#undef PG8_WAIT_V
#undef PG8_WAIT_L
#undef PG8_BAR
#undef PG8_SCHED
}
}
using pg8::bf16_t; using pg8::bf16x8; using pg8::f32x4; using pg8::u32x4; using pg8::u32x2; using pg8::cvt_pk_bf16;
typedef float f32x16 __attribute__((ext_vector_type(16)));
#define LAS __attribute__((address_space(3)))
constexpr int DM = 1024, NBATCH = 16, SEQ = 4096, NH = 16, HD = 64, DFF = 2816, MTOK = NBATCH * SEQ, DEPTH = 4;
constexpr size_t MiB = 1u << 20;
constexpr size_t WS_SSQ = 0, WS_ROPE = 4 * MiB, WS_BAR = 6 * MiB, BAR_BYTES = 16384;
constexpr size_t WS_WQKV_A = 8 * MiB, WS_WO_A = 20 * MiB, WS_WB2 = 24 * MiB, WS_WB3 = 30 * MiB, WS_WO_B = 32 * MiB, WS_WGU = 36 * MiB, WS_WDN = 80 * MiB;
constexpr size_t WS_HB = 104 * MiB, WS_QO = 232 * MiB, WS_K = 360 * MiB, WS_VT = 488 * MiB, WS_ACT = 616 * MiB, WS_END = 968 * MiB;
constexpr size_t SZ_WQKV = (size_t)3072 * 1024 * 2, SZ_WSQ = (size_t)1024 * 1024 * 2, SZ_WGU = (size_t)5632 * 1024 * 2, SZ_WDN = (size_t)1024 * 2816 * 2;
constexpr int BARW_OFF = 155584;
constexpr int LDS_BYTES = 155648;
constexpr int NPHASE = 22;
#ifndef PROBE
#define PROBE 0
#endif

struct TJob { const float* src; const float* gain; bf16_t* dst; int ld, col0, ncols, K, dst_row0, map; };
struct Args { const float* in[13]; float* out; unsigned char* ws; int ph_lo, ph_hi; };
typedef const __attribute__((address_space(4))) Args* ArgsP;
constexpr int NJOBS = 21;
__device__ __forceinline__ int job_items(int j) { if (j < 6) return (j % 3 == 0) ? 16 * 96 : 16 * 32; if (j == 7) return 16 * 64; if (j < 9) return 16 * 32; return ((j - 9) % 3 == 2) ? 44 * 32 : 16 * 88; }
__device__ __forceinline__ TJob get_job(ArgsP ap, int j) {
    TJob J; unsigned char* ws = ap->ws;
    const float* norm_mix = ap->in[1]; const float* norm_ffn = ap->in[8];
    if (j < 6) { const int L = j / 3, k = j % 3;
        if (k == 0) { J.src = ap->in[2] + (size_t)L * 1024 * 3072; J.gain = norm_mix + L * 1024; J.dst = (bf16_t*)(ws + WS_WQKV_A + L * SZ_WQKV); J.ld = 3072; J.ncols = 3072; J.K = 1024; J.map = 1; }
        else if (k == 1) { J.src = ap->in[3] + (size_t)L * 1024 * 1024; J.gain = nullptr; J.dst = (bf16_t*)(ws + WS_WO_A + L * SZ_WSQ); J.ld = 1024; J.ncols = 1024; J.K = 1024; J.map = 0; }
        else { J.src = ap->in[7] + (size_t)L * 1024 * 1024; J.gain = nullptr; J.dst = (bf16_t*)(ws + WS_WO_B + L * SZ_WSQ); J.ld = 1024; J.ncols = 1024; J.K = 1024; J.map = 0; }
        J.col0 = 0; J.dst_row0 = 0; return J; }
    if (j == 6) { J.src = ap->in[6]; J.gain = norm_mix + 2 * 1024; J.dst = (bf16_t*)(ws + WS_WB2); J.ld = 1024; J.col0 = 0; J.ncols = 1024; J.K = 1024; J.dst_row0 = 0; J.map = 1; return J; }
    if (j == 7) { J.src = ap->in[5]; J.gain = ap->in[4]; J.dst = (bf16_t*)(ws + WS_WB2); J.ld = 2048; J.col0 = 0; J.ncols = 2048; J.K = 1024; J.dst_row0 = 1024; J.map = 1; return J; }
    if (j == 8) { J.src = ap->in[6] + (size_t)1024 * 1024; J.gain = norm_mix + 3 * 1024; J.dst = (bf16_t*)(ws + WS_WB3); J.ld = 1024; J.col0 = 0; J.ncols = 1024; J.K = 1024; J.dst_row0 = 0; J.map = 1; return J; }
    { const int L = (j - 9) / 3, k = (j - 9) % 3; J.col0 = 0; J.dst_row0 = 0;
        if (k == 0) { J.src = ap->in[9] + (size_t)L * 1024 * 2816; J.gain = norm_ffn + L * 1024; J.dst = (bf16_t*)(ws + WS_WGU + L * SZ_WGU); J.ld = 2816; J.ncols = 2816; J.K = 1024; J.map = 2; }
        else if (k == 1) { J.src = ap->in[10] + (size_t)L * 1024 * 2816; J.gain = norm_ffn + L * 1024; J.dst = (bf16_t*)(ws + WS_WGU + L * SZ_WGU); J.ld = 2816; J.ncols = 2816; J.K = 1024; J.map = 3; }
        else { J.src = ap->in[11] + (size_t)L * 2816 * 1024; J.gain = nullptr; J.dst = (bf16_t*)(ws + WS_WDN + L * SZ_WDN); J.ld = 1024; J.ncols = 1024; J.K = 2816; J.map = 0; }
        return J; }
}

__device__ __forceinline__ int map_col(int c, int map) {
    if (map == 1) { const int p = c >> 8, hh = (c >> 6) & 3, bj = (c >> 5) & 1, tt = c & 31; return (p << 8) + (bj << 7) + (hh << 5) + tt; }
    if (map == 2) return ((c >> 7) << 8) + (c & 127);
    if (map == 3) return ((c >> 7) << 8) + 128 + (c & 127);
    return c;
}
__device__ __forceinline__ void transpose_item(const TJob& J, LAS float* scr, int item, int lane) {
    const int nblk = J.ncols / 32, kb = item / nblk, nb = item % nblk, k0 = 64 * kb, n0 = 32 * nb;
#pragma unroll
    for (int i = 0; i < 8; ++i) { const int kk = 8 * i + (lane >> 3), ch = lane & 7; const float g = J.gain ? J.gain[k0 + kk] : 1.0f;
        const f32x4 v = __builtin_nontemporal_load((const f32x4*)(J.src + (size_t)(k0 + kk) * J.ld + J.col0 + n0 + 4 * ch));
        *(LAS f32x4*)(scr + kk * 36 + 4 * ch) = v * g; }
    asm volatile("s_waitcnt lgkmcnt(0)" ::: "memory");
    const int c = lane & 7; const int drow = J.dst_row0 + map_col(n0, J.map);
#pragma unroll
    for (int j = 0; j < 4; ++j) { const int n = (lane >> 3) + 8 * j; const LAS float* s = scr + (8 * c) * 36 + n;
        u32x4 o; o.x = cvt_pk_bf16(s[0 * 36], s[1 * 36]); o.y = cvt_pk_bf16(s[2 * 36], s[3 * 36]); o.z = cvt_pk_bf16(s[4 * 36], s[5 * 36]); o.w = cvt_pk_bf16(s[6 * 36], s[7 * 36]);
        *(u32x4*)(J.dst + (size_t)(drow + n) * J.K + k0 + 8 * c) = o; }
    asm volatile("s_waitcnt lgkmcnt(0)" ::: "memory");
}
__device__ __forceinline__ float wave_sum(float v) {
#pragma unroll
    for (int o = 1; o < 64; o <<= 1) v += __shfl_xor(v, o);
    return v;
}
__device__ __forceinline__ void prologue(ArgsP ap, LAS unsigned char* lds, int gw, int ngw, int wave, int lane) {
    LAS float* scr = (LAS float*)(lds + wave * 16384);
    int total = 0;
    for (int j = 0; j < NJOBS; ++j) total += job_items(j);
    for (int it = gw; it < total; it += ngw) {
        int r = it, j = 0;
        for (; j < NJOBS; ++j) { const int n = job_items(j); if (r < n) break; r -= n; }
        const TJob J = get_job(ap, j);
        transpose_item(J, scr, r, lane);
    }
    float* rope = (float*)(ap->ws + WS_ROPE);
    for (int e = gw * 64 + lane; e < SEQ * 32; e += ngw * 64) { const int s = e >> 5, j = e & 31;
        const float inv = __builtin_amdgcn_exp2f(-(float)j * 0.41524101186092033f);
        const float ang = (float)s * inv; double rev = (double)ang * 0.15915494309189535; rev -= __builtin_floor(rev); const float rf = (float)rev;
        rope[s * 64 + j] = __builtin_amdgcn_cosf(rf); rope[s * 64 + 32 + j] = __builtin_amdgcn_sinf(rf); }
    bf16_t* hb = (bf16_t*)(ap->ws + WS_HB); float* ssq = (float*)(ap->ws + WS_SSQ); const float* xin = ap->in[0];
    for (int row = gw; row < MTOK; row += ngw) {
        const f32x4* xr = (const f32x4*)(xin + (size_t)row * DM) + lane; float ss = 0.f; f32x4 v[4];
#pragma unroll
        for (int j = 0; j < 4; ++j) { v[j] = xr[64 * j]; ss += (v[j][0] * v[j][0] + v[j][1] * v[j][1]) + (v[j][2] * v[j][2] + v[j][3] * v[j][3]); }
        ss = wave_sum(ss);
        u32x2* o = (u32x2*)(hb + (size_t)row * DM) + lane;
#pragma unroll
        for (int j = 0; j < 4; ++j) { u32x2 w; w.x = cvt_pk_bf16(v[j][0], v[j][1]); w.y = cvt_pk_bf16(v[j][2], v[j][3]); o[64 * j] = w; }
        if (lane < 16) ssq[(size_t)row * 16 + lane] = (lane == 0) ? ss : 0.f;
    }
}
__device__ __forceinline__ void final_norm(ArgsP ap, int gw, int ngw, int lane) {
    const float* ssq = (const float*)(ap->ws + WS_SSQ); float* outp = ap->out; const float* nf = ap->in[12]; const bf16_t* hb = (const bf16_t*)(ap->ws + WS_HB);
    f32x4 g[4];
#pragma unroll
    for (int j = 0; j < 4; ++j) g[j] = ((const f32x4*)nf)[lane + 64 * j];
    for (int row = gw; row < MTOK; row += 2 * ngw) {
        const int row2 = row + ngw; const bool has2 = row2 < MTOK; const int r2 = has2 ? row2 : row;
        const float rsa = pg8::row_rstd(ssq, (size_t)row), rsb = pg8::row_rstd(ssq, (size_t)r2);
        const u32x2* ha = (const u32x2*)(hb + (size_t)row * DM) + lane; const u32x2* hbp = (const u32x2*)(hb + (size_t)r2 * DM) + lane;
        f32x4* xa = (f32x4*)(outp + (size_t)row * DM) + lane; f32x4* xb = (f32x4*)(outp + (size_t)r2 * DM) + lane;
        u32x2 oa[4], ob[4];
#pragma unroll
        for (int j = 0; j < 4; ++j) { oa[j] = __builtin_nontemporal_load(ha + 64 * j); ob[j] = __builtin_nontemporal_load(hbp + 64 * j); }
#pragma unroll
        for (int j = 0; j < 4; ++j) { f32x4 v;
            v[0] = __uint_as_float(oa[j].x << 16); v[1] = __uint_as_float(oa[j].x & 0xffff0000u); v[2] = __uint_as_float(oa[j].y << 16); v[3] = __uint_as_float(oa[j].y & 0xffff0000u);
            __builtin_nontemporal_store(v * rsa * g[j], xa + 64 * j);
            if (has2) { v[0] = __uint_as_float(ob[j].x << 16); v[1] = __uint_as_float(ob[j].x & 0xffff0000u); v[2] = __uint_as_float(ob[j].y << 16); v[3] = __uint_as_float(ob[j].y & 0xffff0000u);
                __builtin_nontemporal_store(v * rsb * g[j], xb + 64 * j); } }
    }
}

__device__ __forceinline__ bf16x8 pack8(const float* w) {
    u32x4 p; p.x = cvt_pk_bf16(w[0], w[1]); p.y = cvt_pk_bf16(w[2], w[3]); p.z = cvt_pk_bf16(w[4], w[5]); p.w = cvt_pk_bf16(w[6], w[7]);
    return __builtin_bit_cast(bf16x8, p);
}
__device__ __forceinline__ void store_o(bf16_t* orow, const f32x16& o0, const f32x16& o1, float sc, int hi) {
#pragma unroll
    for (int g = 0; g < 4; ++g) {
        u32x2 w; w.x = cvt_pk_bf16(o0[4 * g] * sc, o0[4 * g + 1] * sc); w.y = cvt_pk_bf16(o0[4 * g + 2] * sc, o0[4 * g + 3] * sc); *(u32x2*)(orow + 8 * g + 4 * hi) = w;
        w.x = cvt_pk_bf16(o1[4 * g] * sc, o1[4 * g + 1] * sc); w.y = cvt_pk_bf16(o1[4 * g + 2] * sc, o1[4 * g + 3] * sc); *(u32x2*)(orow + 32 + 8 * g + 4 * hi) = w;
    }
}
constexpr int SCR_PITCH = 144, SCR_BYTES = 32 * SCR_PITCH, SCR_OFF = 40960;
__device__ __forceinline__ void rows_to_lds(LAS unsigned char* scr, const bf16_t* base, int t0, int ts, int lane) {
#pragma unroll
    for (int k = 0; k < 4; ++k) { const int row = 8 * k + (lane >> 3), ch = lane & 7; const u32x4 v = __builtin_nontemporal_load((const u32x4*)(base + (size_t)(t0 + ts * row) * DM + ch * 8)); *(LAS u32x4*)(scr + row * SCR_PITCH + ch * 16) = v; }
}
__device__ __forceinline__ void lds_to_rows(LAS unsigned char* scr, bf16_t* base, int t0, int ts, int lane) {
#pragma unroll
    for (int k = 0; k < 4; ++k) { const int row = 8 * k + (lane >> 3), ch = lane & 7; const u32x4 v = *(LAS u32x4*)(scr + row * SCR_PITCH + ch * 16); __builtin_nontemporal_store(v, (u32x4*)(base + (size_t)(t0 + ts * row) * DM + ch * 8)); }
}
__device__ __forceinline__ void o_to_lds(LAS unsigned char* scr, const f32x16& o0, const f32x16& o1, float sc, int r32, int hi) {
#pragma unroll
    for (int g = 0; g < 4; ++g) {
        u32x2 w; w.x = cvt_pk_bf16(o0[4 * g] * sc, o0[4 * g + 1] * sc); w.y = cvt_pk_bf16(o0[4 * g + 2] * sc, o0[4 * g + 3] * sc); *(LAS u32x2*)(scr + r32 * SCR_PITCH + (8 * g + 4 * hi) * 2) = w;
        w.x = cvt_pk_bf16(o1[4 * g] * sc, o1[4 * g + 1] * sc); w.y = cvt_pk_bf16(o1[4 * g + 2] * sc, o1[4 * g + 3] * sc); *(LAS u32x2*)(scr + r32 * SCR_PITCH + (32 + 8 * g + 4 * hi) * 2) = w;
    }
}
__device__ __forceinline__ void sb_unit(const bf16_t* Q, const bf16_t* Kb, const bf16_t* Vt, bf16_t* O, int bh, int qb, int lane, int cap = 1 << 30) {
    const int b = bh >> 4, h = bh & 15, r32 = lane & 31, hi = lane >> 5;
    const size_t rowbase = (size_t)b * SEQ;
    const bf16_t* qp = Q + (rowbase + qb * 32 + r32) * DM + h * HD + 8 * hi;
    bf16x8 qf[4];
#pragma unroll
    for (int s = 0; s < 4; ++s) qf[s] = *(const bf16x8*)(qp + 16 * s);
    const bf16_t* kp = Kb + (size_t)bh * (128 * 2048) + lane * 8;
    const bf16_t* vp = Vt + (size_t)bh * (128 * 2048) + lane * 8;
    f32x16 o0 = {}, o1 = {}; float P = 1.0f;
    bf16x8 kA[4], vA[4], kB[4], vB[4], kC[4], vC[4];
#define SB_LOAD(KF, VF, JT) do { { const int jt_ = (JT) < 0 ? 0 : (JT); const bf16_t* kt_ = kp + jt_ * 2048; const bf16_t* vt_ = vp + jt_ * 2048; \
        _Pragma("unroll") for (int s = 0; s < 4; ++s) { KF[s] = *(const bf16x8*)(kt_ + 512 * s); VF[s] = *(const bf16x8*)(vt_ + 512 * s); } } } while (0)
#define SB_STEP(KF, VF, JT) do { \
        f32x16 S = {}; \
        _Pragma("unroll") for (int s = 0; s < 4; ++s) S = __builtin_amdgcn_mfma_f32_32x32x16_bf16(KF[s], qf[s], S, 0, 0, 0); \
        float r[16]; const bool diag = ((JT) == qb); \
        _Pragma("unroll") for (int i = 0; i < 16; ++i) { float e = __builtin_amdgcn_exp2f(S[i]); if (diag && (16 * hi + i >= r32)) e = 0.f; r[i] = __builtin_amdgcn_rcpf(1.0f + e); } \
        const float t8a = ((r[8] * r[9]) * (r[10] * r[11])) * ((r[12] * r[13]) * (r[14] * r[15])), t8b = ((r[0] * r[1]) * (r[2] * r[3])) * ((r[4] * r[5]) * (r[6] * r[7])), tot = t8a * t8b; \
        auto rr = __builtin_amdgcn_permlane32_swap(__float_as_uint(tot), __float_as_uint(tot), false, false); \
        const float tot_lo = __uint_as_float(rr[0]), tot_hi = __uint_as_float(rr[1]); \
        float A = hi ? P : P * tot_hi; float B2 = A * t8a; P = P * tot_lo * tot_hi; float w[16];        \
        _Pragma("unroll") for (int i = 7; i >= 0; --i) { const float An = A * r[8 + i]; w[8 + i] = A - An; A = An; const float Bn = B2 * r[i]; w[i] = B2 - Bn; B2 = Bn; } \
        const bf16x8 p0 = pack8(w), p1 = pack8(w + 8); \
        o0 = __builtin_amdgcn_mfma_f32_32x32x16_bf16(VF[0], p0, o0, 0, 0, 0); o0 = __builtin_amdgcn_mfma_f32_32x32x16_bf16(VF[1], p1, o0, 0, 0, 0); \
        o1 = __builtin_amdgcn_mfma_f32_32x32x16_bf16(VF[2], p0, o1, 0, 0, 0); o1 = __builtin_amdgcn_mfma_f32_32x32x16_bf16(VF[3], p1, o1, 0, 0, 0); } while (0)
    SB_LOAD(kA, vA, qb); SB_LOAD(kB, vB, qb - 1);
    for (int jt = qb; jt >= 0 && jt > qb - cap; jt -= 3) {
        SB_LOAD(kC, vC, jt - 2); SB_STEP(kA, vA, jt);     if (jt - 1 < 0 || __ballot(P != 0.0f) == 0ull) break;
        SB_LOAD(kA, vA, jt - 3); SB_STEP(kB, vB, jt - 1); if (jt - 2 < 0 || __ballot(P != 0.0f) == 0ull) break;
        SB_LOAD(kB, vB, jt - 4); SB_STEP(kC, vC, jt - 2); if (__ballot(P != 0.0f) == 0ull) break;
    }
#undef SB_LOAD
#undef SB_STEP
    store_o(O + (rowbase + qb * 32 + r32) * DM + h * HD, o0, o1, 1.0f, hi);
}

struct DTile { int cb, cs, ibase, is, wr, valid; };
template <int MODE> __device__ __forceinline__ DTile dil_decode(int tt, int c, int ib) {
    DTile d;
    if (MODE == 0) { const int w = (ib >> 2) - 1 + (tt >> 2); d.cb = 4 * (tt & 3); d.cs = 1; d.ibase = 8 * w; d.is = 0; d.wr = 128; d.valid = w >= 0; }
    else if (tt < 5) { const int w = ib - 4 + tt; d.cb = c; d.cs = 0; d.ibase = 32 * w; d.is = 8; d.wr = 2048; d.valid = w >= 0; }
    else { const int w = 4 * ib - 4 + (tt - 5); d.cb = c & 3; d.cs = 4; d.ibase = 8 * w; d.is = 0; d.wr = 512; d.valid = w >= 0; }
    return d;
}
__device__ __forceinline__ void dil_load(const DTile& d, const bf16_t* kq, const bf16_t* vq, int rho_m, int j_m, int hi, bf16x8* kf, bf16x8* vf) {
    const int ib0 = d.valid ? d.ibase : 0;
    const bf16_t* kt = kq + (size_t)((d.cb + d.cs * rho_m) * 32 + ((ib0 + d.is * rho_m) >> 3)) * 512;
#pragma unroll
    for (int s = 0; s < 4; ++s) kf[s] = *(const bf16x8*)(kt + s * 128);
#pragma unroll
    for (int u = 0; u < 2; ++u) { const int rho = 2 * hi + u; const bf16_t* vt = vq + (size_t)((d.cb + d.cs * rho) * 32 + ((ib0 + d.is * rho) >> 3)) * 512;
        vf[u] = *(const bf16x8*)(vt); vf[2 + u] = *(const bf16x8*)(vt + 256); }
}
__device__ __forceinline__ void dil_load_u(const bf16_t* kbh, const bf16_t* vbh, unsigned sbase, unsigned kro, unsigned vro0, unsigned vro1, bf16x8* kf, bf16x8* vf) {
    const bf16_t* kt = kbh + sbase; const bf16_t* vt = vbh + sbase;
#pragma unroll
    for (int s = 0; s < 4; ++s) kf[s] = *(const bf16x8*)(kt + (kro + s * 128));
    vf[0] = *(const bf16x8*)(vt + vro0); vf[1] = *(const bf16x8*)(vt + vro1); vf[2] = *(const bf16x8*)(vt + (vro0 + 256)); vf[3] = *(const bf16x8*)(vt + (vro1 + 256));
}
template <int MODE> __device__ __forceinline__ void dil_unit(const bf16_t* Q, const bf16_t* Kb, const bf16_t* Vt, bf16_t* O, bf16_t* X1, float* LSE, int bh, int c, int ib, int lane, LAS unsigned char* scr, int ntcap = 64) {
    constexpr int NT = MODE == 0 ? 8 : 13;
    const int b = bh >> 4, h = bh & 15, r32 = lane & 31, hi = lane >> 5;
    const size_t rowbase = (size_t)b * SEQ;
    const int tq = MODE == 0 ? 32 * ib + r32 : c + 16 * (32 * ib + r32);
    const int t0 = MODE == 0 ? 32 * ib : c + 512 * ib, ts = MODE == 0 ? 1 : 16;
    rows_to_lds(scr, Q + rowbase * DM + h * HD, t0, ts, lane);
    bf16x8 qf[4];
#pragma unroll
    for (int s = 0; s < 4; ++s) qf[s] = *(LAS bf16x8*)(scr + r32 * SCR_PITCH + (2 * s + hi) * 16);
    const int u_m = (r32 >> 4) & 1, hi_m = (r32 >> 2) & 1, j_m = (r32 & 3) + 4 * ((r32 >> 3) & 1), rho_m = 2 * hi_m + u_m;
    const bf16_t* kq = Kb + (size_t)bh * (16 * 32 * 512) + (8 * hi + j_m) * 8;
    const bf16_t* vq = Vt + (size_t)bh * (16 * 32 * 512) + r32 * 8;
    f32x16 o0 = {}, o1 = {}; float mrun = -1e30f, l = 0.f;
    bf16x8 kA[4], vA[4], kB[4], vB[4], kC[4], vC[4];
    const bf16_t* kbh = Kb + (size_t)bh * (16 * 32 * 512); const bf16_t* vbh = Vt + (size_t)bh * (16 * 32 * 512);
    const unsigned kl_ = (unsigned)((8 * hi + j_m) * 8), vl_ = (unsigned)(r32 * 8);
    const unsigned kro16 = kl_ + rho_m * 512u, kro4 = kl_ + rho_m * 65536u, vro16 = vl_ + (2 * hi) * 512u, vro4 = vl_ + (2 * hi) * 65536u;
#define DL_LOAD(KF, VF, TT) do { const int tt_ = (TT) < NT ? (TT) : NT - 1; \
        if (MODE == 1) { const bool r16_ = tt_ < 5; const int w_ = r16_ ? ib - 4 + tt_ : 4 * ib - 4 + (tt_ - 5); const int wc_ = w_ < 0 ? 0 : w_; \
            const unsigned sb_ = r16_ ? (unsigned)((c * 32 + 4 * wc_) * 512) : (unsigned)(((c & 3) * 32 + wc_) * 512); \
            dil_load_u(kbh, vbh, sb_, r16_ ? kro16 : kro4, r16_ ? vro16 : vro4, r16_ ? vro16 + 512u : vro4 + 65536u, KF, VF); } \
        else { const DTile d_ = dil_decode<MODE>(tt_, c, ib); dil_load(d_, kq, vq, rho_m, j_m, hi, KF, VF); } } while (0)
#define DL_STEP(KF, VF, TT) do { const DTile dc = dil_decode<MODE>((TT), c, ib); if ((TT) < NT && (TT) < ntcap && dc.valid) { \
        f32x16 S = {}; \
        _Pragma("unroll") for (int s = 0; s < 4; ++s) S = __builtin_amdgcn_mfma_f32_32x32x16_bf16(KF[s], qf[s], S, 0, 0, 0); \
        const int stride = 16 * dc.is + dc.cs; const int dA = tq - 16 * dc.ibase - dc.cb - 2 * hi * stride, dB = dA - stride; \
        float z[16]; \
        if (MODE == 1 && (TT) >= 1 && (TT) <= 3) { _Pragma("unroll") for (int i = 0; i < 16; ++i) z[i] = S[i]; }        \
        else { _Pragma("unroll") for (int i = 0; i < 16; ++i) { const bool ok = (unsigned)(((i >> 3) ? dB : dA) - 16 * (i & 7)) <= (unsigned)dc.wr; z[i] = ok ? S[i] : -INFINITY; } } \
        float mx = __builtin_fmaxf(__builtin_fmaxf(__builtin_fmaxf(__builtin_fmaxf(z[0], z[1]), __builtin_fmaxf(z[2], z[3])), __builtin_fmaxf(__builtin_fmaxf(z[4], z[5]), __builtin_fmaxf(z[6], z[7]))), \
                                   __builtin_fmaxf(__builtin_fmaxf(__builtin_fmaxf(z[8], z[9]), __builtin_fmaxf(z[10], z[11])), __builtin_fmaxf(__builtin_fmaxf(z[12], z[13]), __builtin_fmaxf(z[14], z[15])))); \
        auto rr = __builtin_amdgcn_permlane32_swap(__float_as_uint(mx), __float_as_uint(mx), false, false); \
        mx = fmaxf(__uint_as_float(rr[0]), __uint_as_float(rr[1])); \
        if (__ballot(mx > mrun) != 0ull) { const float mnew = fmaxf(mrun, mx); const float alpha = __builtin_amdgcn_exp2f(mrun - mnew); mrun = mnew; l *= alpha; \
            _Pragma("unroll") for (int i = 0; i < 16; ++i) { o0[i] *= alpha; o1[i] *= alpha; } } \
        float p[16]; \
        _Pragma("unroll") for (int i = 0; i < 16; ++i) p[i] = __builtin_amdgcn_exp2f(z[i] - mrun); \
        l += (((p[0] + p[1]) + (p[2] + p[3])) + ((p[4] + p[5]) + (p[6] + p[7]))) + (((p[8] + p[9]) + (p[10] + p[11])) + ((p[12] + p[13]) + (p[14] + p[15]))); \
        const bf16x8 p0 = pack8(p), p1 = pack8(p + 8); \
        o0 = __builtin_amdgcn_mfma_f32_32x32x16_bf16(VF[0], p0, o0, 0, 0, 0); o0 = __builtin_amdgcn_mfma_f32_32x32x16_bf16(VF[1], p1, o0, 0, 0, 0); \
        o1 = __builtin_amdgcn_mfma_f32_32x32x16_bf16(VF[2], p0, o1, 0, 0, 0); o1 = __builtin_amdgcn_mfma_f32_32x32x16_bf16(VF[3], p1, o1, 0, 0, 0); } } while (0)
    DL_LOAD(kA, vA, 0); DL_LOAD(kB, vB, 1);
    for (int tt = 0; tt < NT; tt += 3) {
        DL_LOAD(kC, vC, tt + 2); DL_STEP(kA, vA, tt);
        DL_LOAD(kA, vA, tt + 3); DL_STEP(kB, vB, tt + 1);
        DL_LOAD(kB, vB, tt + 4); DL_STEP(kC, vC, tt + 2);
    }
#undef DL_LOAD
#undef DL_STEP
    auto rr = __builtin_amdgcn_permlane32_swap(__float_as_uint(l), __float_as_uint(l), false, false);
    const float lt = __uint_as_float(rr[0]) + __uint_as_float(rr[1]);
    const size_t orow = (rowbase + tq) * DM + h * HD;
    if (MODE == 0) {
        o_to_lds(scr, o0, o1, 1.0f / lt, r32, hi); lds_to_rows(scr, X1 + rowbase * DM + h * HD, t0, ts, lane);
        if (hi == 0) LSE[(rowbase + tq) * 16 + h] = mrun + __builtin_amdgcn_logf(lt);
    } else {
        rows_to_lds(scr, X1 + rowbase * DM + h * HD, t0, ts, lane);
        const float lse1 = LSE[(rowbase + tq) * 16 + h];
        const float M = fmaxf(mrun, lse1), w2 = __builtin_amdgcn_exp2f(mrun - M), w1 = __builtin_amdgcn_exp2f(lse1 - M), inv = 1.0f / (lt * w2 + w1), a2 = w2 * inv, a1 = w1 * inv;
#pragma unroll
        for (int g = 0; g < 4; ++g) {
            const u32x2 x0 = *(LAS u32x2*)(scr + r32 * SCR_PITCH + (8 * g + 4 * hi) * 2), x1 = *(LAS u32x2*)(scr + r32 * SCR_PITCH + (32 + 8 * g + 4 * hi) * 2);
            o0[4 * g] = o0[4 * g] * a2 + __uint_as_float(x0.x << 16) * a1; o0[4 * g + 1] = o0[4 * g + 1] * a2 + __uint_as_float(x0.x & 0xffff0000u) * a1;
            o0[4 * g + 2] = o0[4 * g + 2] * a2 + __uint_as_float(x0.y << 16) * a1; o0[4 * g + 3] = o0[4 * g + 3] * a2 + __uint_as_float(x0.y & 0xffff0000u) * a1;
            o1[4 * g] = o1[4 * g] * a2 + __uint_as_float(x1.x << 16) * a1; o1[4 * g + 1] = o1[4 * g + 1] * a2 + __uint_as_float(x1.x & 0xffff0000u) * a1;
            o1[4 * g + 2] = o1[4 * g + 2] * a2 + __uint_as_float(x1.y << 16) * a1; o1[4 * g + 3] = o1[4 * g + 3] * a2 + __uint_as_float(x1.y & 0xffff0000u) * a1;
        }
        o_to_lds(scr, o0, o1, 1.0f, r32, hi); lds_to_rows(scr, O + rowbase * DM + h * HD, t0, ts, lane);
    }
}


#define ATT_WAITBAR() asm volatile("s_waitcnt lgkmcnt(0)\n\ts_barrier" ::: "memory")
typedef LAS bf16x8* lds_v8;
__device__ __forceinline__ void sb_group(const bf16_t* Q, const bf16_t* Kb, const bf16_t* Vt, bf16_t* O, int bh, int g, int tid, LAS unsigned char* lds) {
    const int lane = tid & 63, wave = __builtin_amdgcn_readfirstlane(tid >> 6), r32 = lane & 31, hi = lane >> 5;
    const int b = bh >> 4, h = bh & 15, qb = 8 * g + wave, top = 8 * g + 7;
    const size_t rowbase = (size_t)b * SEQ;
    LAS unsigned char* scr = lds + SCR_OFF + wave * SCR_BYTES;
    rows_to_lds(scr, Q + rowbase * DM + h * HD, qb * 32, 1, lane);
    bf16x8 qf[4];
#pragma unroll
    for (int s = 0; s < 4; ++s) qf[s] = *(LAS bf16x8*)(scr + r32 * SCR_PITCH + (2 * s + hi) * 16);
    const bf16_t* src = ((tid < 256) ? Kb : Vt) + (size_t)bh * (128 * 2048) + (tid & 255) * 8;
    LAS unsigned char* dst = lds + tid * 16;
    LAS unsigned char* rdp = lds + lane * 16;
    volatile LAS unsigned* flags = (volatile LAS unsigned*)(lds + 32768);
#define SG_GLOAD(JT) (*(const bf16x8*)(src + (size_t)((JT) < 0 ? 0 : (JT)) * 2048))
    bf16x8 r0 = SG_GLOAD(top), r1 = SG_GLOAD(top - 1), rh = SG_GLOAD(top - 2);
    ATT_WAITBAR();
    *(lds_v8)(dst) = r0; *(lds_v8)(dst + 8192) = r1;
    f32x16 o0 = {}, o1 = {}; float P = 1.0f;
    for (int t = 0; ; ++t) {
        const int jt = top - t, slot = (t & 3) * 8192;
        const bf16x8 rn = SG_GLOAD(jt - 3);
        *(lds_v8)(dst + ((t + 2) & 3) * 8192) = rh;
        const bool mine = (jt <= qb) && (jt >= 0) && (__ballot(P != 0.0f) != 0ull);
        if (lane == 0) flags[(t & 1) * 8 + wave] = (jt >= 0 && (jt > qb || mine)) ? 1u : 0u;
        ATT_WAITBAR();
        { const u32x4 fa = *(LAS u32x4*)(lds + 32768 + (t & 1) * 32), fb = *(LAS u32x4*)(lds + 32768 + (t & 1) * 32 + 16);
          if (((fa.x | fa.y) | (fa.z | fa.w) | (fb.x | fb.y) | (fb.z | fb.w)) == 0u) break; }
        if (mine) {
            bf16x8 KF[4], VF[4];
#pragma unroll
            for (int s = 0; s < 4; ++s) { KF[s] = *(lds_v8)(rdp + slot + s * 1024); VF[s] = *(lds_v8)(rdp + slot + 4096 + s * 1024); }
            f32x16 S = {};
#pragma unroll
            for (int s = 0; s < 4; ++s) S = __builtin_amdgcn_mfma_f32_32x32x16_bf16(KF[s], qf[s], S, 0, 0, 0);
            float r[16]; const bool diag = (jt == qb);
#pragma unroll
            for (int i = 0; i < 16; ++i) { float e = __builtin_amdgcn_exp2f(S[i]); if (diag && (16 * hi + i >= r32)) e = 0.f; r[i] = __builtin_amdgcn_rcpf(1.0f + e); }
            const float t8a = ((r[8] * r[9]) * (r[10] * r[11])) * ((r[12] * r[13]) * (r[14] * r[15])), t8b = ((r[0] * r[1]) * (r[2] * r[3])) * ((r[4] * r[5]) * (r[6] * r[7])), tot = t8a * t8b;
            auto rr = __builtin_amdgcn_permlane32_swap(__float_as_uint(tot), __float_as_uint(tot), false, false);
            const float tot_lo = __uint_as_float(rr[0]), tot_hi = __uint_as_float(rr[1]);
            float A = hi ? P : P * tot_hi; float B2 = A * t8a; P = P * tot_lo * tot_hi; float w[16];
#pragma unroll
            for (int i = 7; i >= 0; --i) { const float An = A * r[8 + i]; w[8 + i] = A - An; A = An; const float Bn = B2 * r[i]; w[i] = B2 - Bn; B2 = Bn; }
            const bf16x8 p0 = pack8(w), p1 = pack8(w + 8);
            o0 = __builtin_amdgcn_mfma_f32_32x32x16_bf16(VF[0], p0, o0, 0, 0, 0); o0 = __builtin_amdgcn_mfma_f32_32x32x16_bf16(VF[1], p1, o0, 0, 0, 0);
            o1 = __builtin_amdgcn_mfma_f32_32x32x16_bf16(VF[2], p0, o1, 0, 0, 0); o1 = __builtin_amdgcn_mfma_f32_32x32x16_bf16(VF[3], p1, o1, 0, 0, 0);
        }
        rh = rn;
    }
#undef SG_GLOAD
    o_to_lds(scr, o0, o1, 1.0f, r32, hi);
    lds_to_rows(scr, O + rowbase * DM + h * HD, qb * 32, 1, lane);
}
constexpr int SBW_TILES = 14, SBW_SCR = SBW_TILES * 8192;
__device__ __forceinline__ void sb_step(const bf16x8* KF, const bf16x8* VF, const bf16x8* qf, f32x16& o0, f32x16& o1, float& P, bool diag, int r32, int hi) {
    f32x16 S = {};
#pragma unroll
    for (int s = 0; s < 4; ++s) S = __builtin_amdgcn_mfma_f32_32x32x16_bf16(KF[s], qf[s], S, 0, 0, 0);
    float r[16];
#pragma unroll
    for (int i = 0; i < 16; ++i) { float e = __builtin_amdgcn_exp2f(S[i]); if (diag && (16 * hi + i >= r32)) e = 0.f; r[i] = __builtin_amdgcn_rcpf(1.0f + e); }
    const float t8a = ((r[8] * r[9]) * (r[10] * r[11])) * ((r[12] * r[13]) * (r[14] * r[15])), t8b = ((r[0] * r[1]) * (r[2] * r[3])) * ((r[4] * r[5]) * (r[6] * r[7])), tot = t8a * t8b;
    auto rr = __builtin_amdgcn_permlane32_swap(__float_as_uint(tot), __float_as_uint(tot), false, false);
    const float tot_lo = __uint_as_float(rr[0]), tot_hi = __uint_as_float(rr[1]);
    float A = hi ? P : P * tot_hi; float B2 = A * t8a; P = P * tot_lo * tot_hi; float w[16];
#pragma unroll
    for (int i = 7; i >= 0; --i) { const float An = A * r[8 + i]; w[8 + i] = A - An; A = An; const float Bn = B2 * r[i]; w[i] = B2 - Bn; B2 = Bn; }
    const bf16x8 p0 = pack8(w), p1 = pack8(w + 8);
    o0 = __builtin_amdgcn_mfma_f32_32x32x16_bf16(VF[0], p0, o0, 0, 0, 0); o0 = __builtin_amdgcn_mfma_f32_32x32x16_bf16(VF[1], p1, o0, 0, 0, 0);
    o1 = __builtin_amdgcn_mfma_f32_32x32x16_bf16(VF[2], p0, o1, 0, 0, 0); o1 = __builtin_amdgcn_mfma_f32_32x32x16_bf16(VF[3], p1, o1, 0, 0, 0);
}
__device__ __forceinline__ void sb_groups(const bf16_t* Q, const bf16_t* Kb, const bf16_t* Vt, bf16_t* O, int bid, int G, int tid, LAS unsigned char* lds) {
    const int lane = tid & 63, wave = __builtin_amdgcn_readfirstlane(tid >> 6), r32 = lane & 31, hi = lane >> 5;
    LAS unsigned char* scr = lds + SBW_SCR + wave * SCR_BYTES;
    LAS unsigned char* wdst = lds + tid * 16;
    LAS unsigned char* rdp = lds + lane * 16;
    bf16x8 W[SBW_TILES]; u32x4 QR[4];
#define SBW_ITEM(U, BH, GR) const int BH = (U) & 255, GR = (((U) >> 8) & 1) ? 15 - ((U) >> 9) : ((U) >> 9)
#define SBW_PREFETCH(U) do { SBW_ITEM(U, bh_, g_); const int top_ = 8 * g_ + 7; \
        const bf16_t* src_ = ((tid < 256) ? Kb : Vt) + (size_t)bh_ * (128 * 2048) + (tid & 255) * 8; \
        _Pragma("unroll") for (int k = 0; k < SBW_TILES; ++k) { const int jt_ = top_ - k; W[k] = *(const bf16x8*)(src_ + (size_t)(jt_ < 0 ? 0 : jt_) * 2048); } \
        const bf16_t* qb_ = Q + ((size_t)(bh_ >> 4) * SEQ) * DM + (bh_ & 15) * HD; \
        _Pragma("unroll") for (int k = 0; k < 4; ++k) QR[k] = __builtin_nontemporal_load((const u32x4*)(qb_ + (size_t)((8 * g_ + wave) * 32 + 8 * k + (lane >> 3)) * DM + (lane & 7) * 8)); } while (0)
    if (bid < 4096) SBW_PREFETCH(bid);
    for (int unit = bid; unit < 4096; unit += G) {
        SBW_ITEM(unit, bh, g);
        const int b = bh >> 4, h = bh & 15, qb = 8 * g + wave, top = 8 * g + 7, wlo = top - (SBW_TILES - 1);
        const size_t rowbase = (size_t)b * SEQ;
        ATT_WAITBAR();
#pragma unroll
        for (int k = 0; k < SBW_TILES; ++k) *(lds_v8)(wdst + k * 8192) = W[k];
#pragma unroll
        for (int k = 0; k < 4; ++k) *(LAS u32x4*)(scr + (8 * k + (lane >> 3)) * SCR_PITCH + (lane & 7) * 16) = QR[k];
        ATT_WAITBAR();
        if (unit + G < 4096) SBW_PREFETCH(unit + G);
        bf16x8 qf[4];
#pragma unroll
        for (int s = 0; s < 4; ++s) qf[s] = *(LAS bf16x8*)(scr + r32 * SCR_PITCH + (2 * s + hi) * 16);
        f32x16 o0 = {}, o1 = {}; float P = 1.0f; int jt = qb;
        for (; jt >= 0 && jt >= wlo; --jt) {
            const int slot = (top - jt) * 8192; bf16x8 KF[4], VF[4];
#pragma unroll
            for (int s = 0; s < 4; ++s) { KF[s] = *(lds_v8)(rdp + slot + s * 1024); VF[s] = *(lds_v8)(rdp + slot + 4096 + s * 1024); }
            sb_step(KF, VF, qf, o0, o1, P, jt == qb, r32, hi);
            if (__ballot(P != 0.0f) == 0ull) { jt = -1; break; }
        }
        for (; jt >= 0; --jt) {
            const bf16_t* kt = Kb + (size_t)bh * (128 * 2048) + (size_t)jt * 2048 + lane * 8; const bf16_t* vt = Vt + (size_t)bh * (128 * 2048) + (size_t)jt * 2048 + lane * 8; bf16x8 KF[4], VF[4];
#pragma unroll
            for (int s = 0; s < 4; ++s) { KF[s] = *(const bf16x8*)(kt + 512 * s); VF[s] = *(const bf16x8*)(vt + 512 * s); }
            sb_step(KF, VF, qf, o0, o1, P, false, r32, hi);
            if (__ballot(P != 0.0f) == 0ull) break;
        }
        o_to_lds(scr, o0, o1, 1.0f, r32, hi);
        lds_to_rows(scr, O + rowbase * DM + h * HD, qb * 32, 1, lane);
    }
#undef SBW_ITEM
#undef SBW_PREFETCH
}
__device__ __forceinline__ void dil_group0(const bf16_t* Q, const bf16_t* Kb, const bf16_t* Vt, bf16_t* X1, float* LSE, int bh, int g, int tid, LAS unsigned char* lds) {
    const int lane = tid & 63, wave = __builtin_amdgcn_readfirstlane(tid >> 6), r32 = lane & 31, hi = lane >> 5;
    const int b = bh >> 4, h = bh & 15, blk = 8 * g + wave, tq = 32 * blk + r32, vlo = wave >> 2;
    const size_t rowbase = (size_t)b * SEQ;
    LAS unsigned char* scr = lds + SCR_OFF + wave * SCR_BYTES;
    rows_to_lds(scr, Q + rowbase * DM + h * HD, 32 * blk, 1, lane);
    bf16x8 qf[4];
#pragma unroll
    for (int s = 0; s < 4; ++s) qf[s] = *(LAS bf16x8*)(scr + r32 * SCR_PITCH + (2 * s + hi) * 16);
    const int u_m = (r32 >> 4) & 1, hi_m = (r32 >> 2) & 1, j_m = (r32 & 3) + 4 * ((r32 >> 3) & 1), rho_m = 2 * hi_m + u_m;
    const int part = tid >> 6, rho_s = part & 3;
    const bf16_t* src = ((part < 4) ? Kb : Vt) + (size_t)bh * (16 * 32 * 512) + (size_t)rho_s * (32 * 512) + (tid & 63) * 8;
    LAS unsigned char* dst = lds + part * 1024 + (tid & 63) * 16;
    LAS unsigned char* krd = lds + rho_m * 1024 + (hi * 8 + j_m) * 16;
    LAS unsigned char* vrd = lds + 4096 + (2 * hi) * 1024 + r32 * 16;
#define DG_GLOAD(T) (*(const bf16x8*)(src + (size_t)((((T) < 12 ? (T) : 11) & 3) * 4 * 32 + (2 * g - 1 + (((T) < 12 ? (T) : 11) >> 2) < 0 ? 0 : 2 * g - 1 + (((T) < 12 ? (T) : 11) >> 2))) * 512))
    bf16x8 r0 = DG_GLOAD(0), r1 = DG_GLOAD(1), rh = DG_GLOAD(2);
    ATT_WAITBAR();
    *(lds_v8)(dst) = r0; *(lds_v8)(dst + 8192) = r1;
    f32x16 o0 = {}, o1 = {}; float mrun = -1e30f, l = 0.f;
    for (int t = 0; t < 12; ++t) {
        const int v = t >> 2, a = t & 3, w = 2 * g - 1 + v, slot = (t & 3) * 8192;
        const bf16x8 rn = DG_GLOAD(t + 3);
        *(lds_v8)(dst + ((t + 2) & 3) * 8192) = rh;
        ATT_WAITBAR();
        if (w >= 0 && (v == vlo || v == vlo + 1)) {
            bf16x8 KF[4], VF[4];
#pragma unroll
            for (int s = 0; s < 4; ++s) KF[s] = *(lds_v8)(krd + slot + s * 256);
            VF[0] = *(lds_v8)(vrd + slot); VF[1] = *(lds_v8)(vrd + slot + 1024); VF[2] = *(lds_v8)(vrd + slot + 512); VF[3] = *(lds_v8)(vrd + slot + 1024 + 512);
            f32x16 S = {};
#pragma unroll
            for (int s = 0; s < 4; ++s) S = __builtin_amdgcn_mfma_f32_32x32x16_bf16(KF[s], qf[s], S, 0, 0, 0);
            const int dA = tq - 128 * w - 4 * a - 2 * hi, dB = dA - 1;
            float z[16];
#pragma unroll
            for (int i = 0; i < 16; ++i) { const bool ok = (unsigned)(((i >> 3) ? dB : dA) - 16 * (i & 7)) <= 128u; z[i] = ok ? S[i] : -INFINITY; }
            float mx = __builtin_fmaxf(__builtin_fmaxf(__builtin_fmaxf(__builtin_fmaxf(z[0], z[1]), __builtin_fmaxf(z[2], z[3])), __builtin_fmaxf(__builtin_fmaxf(z[4], z[5]), __builtin_fmaxf(z[6], z[7]))),
                                       __builtin_fmaxf(__builtin_fmaxf(__builtin_fmaxf(z[8], z[9]), __builtin_fmaxf(z[10], z[11])), __builtin_fmaxf(__builtin_fmaxf(z[12], z[13]), __builtin_fmaxf(z[14], z[15]))));
            auto rr = __builtin_amdgcn_permlane32_swap(__float_as_uint(mx), __float_as_uint(mx), false, false);
            mx = fmaxf(__uint_as_float(rr[0]), __uint_as_float(rr[1]));
            if (__ballot(mx > mrun) != 0ull) { const float mnew = fmaxf(mrun, mx); const float alpha = __builtin_amdgcn_exp2f(mrun - mnew); mrun = mnew; l *= alpha;
#pragma unroll
                for (int i = 0; i < 16; ++i) { o0[i] *= alpha; o1[i] *= alpha; } }
            float p[16];
#pragma unroll
            for (int i = 0; i < 16; ++i) p[i] = __builtin_amdgcn_exp2f(z[i] - mrun);
            l += (((p[0] + p[1]) + (p[2] + p[3])) + ((p[4] + p[5]) + (p[6] + p[7]))) + (((p[8] + p[9]) + (p[10] + p[11])) + ((p[12] + p[13]) + (p[14] + p[15])));
            const bf16x8 p0 = pack8(p), p1 = pack8(p + 8);
            o0 = __builtin_amdgcn_mfma_f32_32x32x16_bf16(VF[0], p0, o0, 0, 0, 0); o0 = __builtin_amdgcn_mfma_f32_32x32x16_bf16(VF[1], p1, o0, 0, 0, 0);
            o1 = __builtin_amdgcn_mfma_f32_32x32x16_bf16(VF[2], p0, o1, 0, 0, 0); o1 = __builtin_amdgcn_mfma_f32_32x32x16_bf16(VF[3], p1, o1, 0, 0, 0);
        }
        rh = rn;
    }
#undef DG_GLOAD
    auto rr = __builtin_amdgcn_permlane32_swap(__float_as_uint(l), __float_as_uint(l), false, false);
    const float lt = __uint_as_float(rr[0]) + __uint_as_float(rr[1]);
    o_to_lds(scr, o0, o1, 1.0f / lt, r32, hi);
    lds_to_rows(scr, X1 + rowbase * DM + h * HD, 32 * blk, 1, lane);
    if (hi == 0) LSE[(rowbase + tq) * 16 + h] = mrun + __builtin_amdgcn_logf(lt);
}

__device__ __forceinline__ void dil_groups0(const bf16_t* Q, const bf16_t* Kb, const bf16_t* Vt, bf16_t* X1, float* LSE, bool xo, int xcd, int myr, int bid, int G, int tid, LAS unsigned char* lds) {
    const int lane = tid & 63, wave = __builtin_amdgcn_readfirstlane(tid >> 6), r32 = lane & 31, hi = lane >> 5, vlo = wave >> 2;
    LAS unsigned char* scr = lds + SBW_SCR + wave * SCR_BYTES;
    const int part = tid >> 6, rho_s = part & 3;
    LAS unsigned char* wdst = lds + part * 1024 + (tid & 63) * 16;
    const int u_m = (r32 >> 4) & 1, hi_m = (r32 >> 2) & 1, j_m = (r32 & 3) + 4 * ((r32 >> 3) & 1), rho_m = 2 * hi_m + u_m;
    LAS unsigned char* krd = lds + rho_m * 1024 + (hi * 8 + j_m) * 16;
    LAS unsigned char* vrd = lds + 4096 + (2 * hi) * 1024 + r32 * 16;
    const int nit = xo ? 16 : (4096 - bid + G - 1) / G;
    bf16x8 W[12]; u32x4 QR[4];
#define DG_ITEM(I, BH, GR) const int u__##BH = xo ? myr + 32 * (I) : bid + G * (I); const int BH = xo ? xcd * 32 + (u__##BH >> 4) : (u__##BH >> 4), GR = u__##BH & 15
#define DG_PREFETCH(I) do { DG_ITEM(I, bh_, g_); \
        const bf16_t* src_ = ((part < 4) ? Kb : Vt) + (size_t)bh_ * (16 * 32 * 512) + (size_t)rho_s * (32 * 512) + (tid & 63) * 8; \
        _Pragma("unroll") for (int t = 0; t < 12; ++t) { const int w_ = 2 * g_ - 1 + (t >> 2); W[t] = *(const bf16x8*)(src_ + (size_t)((t & 3) * 4 * 32 + (w_ < 0 ? 0 : w_)) * 512); } \
        const bf16_t* qb_ = Q + ((size_t)(bh_ >> 4) * SEQ) * DM + (bh_ & 15) * HD; \
        _Pragma("unroll") for (int k = 0; k < 4; ++k) QR[k] = __builtin_nontemporal_load((const u32x4*)(qb_ + (size_t)((8 * g_ + wave) * 32 + 8 * k + (lane >> 3)) * DM + (lane & 7) * 8)); } while (0)
    if (nit > 0) DG_PREFETCH(0);
    for (int it = 0; it < nit; ++it) {
        DG_ITEM(it, bh, g);
        const int b = bh >> 4, h = bh & 15, blk = 8 * g + wave, tq = 32 * blk + r32;
        const size_t rowbase = (size_t)b * SEQ;
        ATT_WAITBAR();
#pragma unroll
        for (int t = 0; t < 12; ++t) *(lds_v8)(wdst + t * 8192) = W[t];
#pragma unroll
        for (int k = 0; k < 4; ++k) *(LAS u32x4*)(scr + (8 * k + (lane >> 3)) * SCR_PITCH + (lane & 7) * 16) = QR[k];
        ATT_WAITBAR();
        if (it + 1 < nit) DG_PREFETCH(it + 1);
        bf16x8 qf[4];
#pragma unroll
        for (int s = 0; s < 4; ++s) qf[s] = *(LAS bf16x8*)(scr + r32 * SCR_PITCH + (2 * s + hi) * 16);
        f32x16 o0 = {}, o1 = {}; float mrun = -1e30f, l = 0.f;
        for (int t = 4 * vlo; t < 4 * vlo + 8; ++t) {
            const int v = t >> 2, a = t & 3, w = 2 * g - 1 + v, slot = t * 8192;
            if (w < 0) continue;
            bf16x8 KF[4], VF[4];
#pragma unroll
            for (int s = 0; s < 4; ++s) KF[s] = *(lds_v8)(krd + slot + s * 256);
            VF[0] = *(lds_v8)(vrd + slot); VF[1] = *(lds_v8)(vrd + slot + 1024); VF[2] = *(lds_v8)(vrd + slot + 512); VF[3] = *(lds_v8)(vrd + slot + 1024 + 512);
            f32x16 S = {};
#pragma unroll
            for (int s = 0; s < 4; ++s) S = __builtin_amdgcn_mfma_f32_32x32x16_bf16(KF[s], qf[s], S, 0, 0, 0);
            const int dA = tq - 128 * w - 4 * a - 2 * hi, dB = dA - 1;
            float z[16];
#pragma unroll
            for (int i = 0; i < 16; ++i) { const bool ok = (unsigned)(((i >> 3) ? dB : dA) - 16 * (i & 7)) <= 128u; z[i] = ok ? S[i] : -INFINITY; }
            float mx = __builtin_fmaxf(__builtin_fmaxf(__builtin_fmaxf(__builtin_fmaxf(z[0], z[1]), __builtin_fmaxf(z[2], z[3])), __builtin_fmaxf(__builtin_fmaxf(z[4], z[5]), __builtin_fmaxf(z[6], z[7]))),
                                       __builtin_fmaxf(__builtin_fmaxf(__builtin_fmaxf(z[8], z[9]), __builtin_fmaxf(z[10], z[11])), __builtin_fmaxf(__builtin_fmaxf(z[12], z[13]), __builtin_fmaxf(z[14], z[15]))));
            auto rr = __builtin_amdgcn_permlane32_swap(__float_as_uint(mx), __float_as_uint(mx), false, false);
            mx = fmaxf(__uint_as_float(rr[0]), __uint_as_float(rr[1]));
            if (__ballot(mx > mrun) != 0ull) { const float mnew = fmaxf(mrun, mx); const float alpha = __builtin_amdgcn_exp2f(mrun - mnew); mrun = mnew; l *= alpha;
#pragma unroll
                for (int i = 0; i < 16; ++i) { o0[i] *= alpha; o1[i] *= alpha; } }
            float p[16];
#pragma unroll
            for (int i = 0; i < 16; ++i) p[i] = __builtin_amdgcn_exp2f(z[i] - mrun);
            l += (((p[0] + p[1]) + (p[2] + p[3])) + ((p[4] + p[5]) + (p[6] + p[7]))) + (((p[8] + p[9]) + (p[10] + p[11])) + ((p[12] + p[13]) + (p[14] + p[15])));
            const bf16x8 p0 = pack8(p), p1 = pack8(p + 8);
            o0 = __builtin_amdgcn_mfma_f32_32x32x16_bf16(VF[0], p0, o0, 0, 0, 0); o0 = __builtin_amdgcn_mfma_f32_32x32x16_bf16(VF[1], p1, o0, 0, 0, 0);
            o1 = __builtin_amdgcn_mfma_f32_32x32x16_bf16(VF[2], p0, o1, 0, 0, 0); o1 = __builtin_amdgcn_mfma_f32_32x32x16_bf16(VF[3], p1, o1, 0, 0, 0);
        }
        auto rr = __builtin_amdgcn_permlane32_swap(__float_as_uint(l), __float_as_uint(l), false, false);
        const float lt = __uint_as_float(rr[0]) + __uint_as_float(rr[1]);
        o_to_lds(scr, o0, o1, 1.0f / lt, r32, hi);
        lds_to_rows(scr, X1 + rowbase * DM + h * HD, 32 * blk, 1, lane);
        if (hi == 0) LSE[(rowbase + tq) * 16 + h] = mrun + __builtin_amdgcn_logf(lt);
    }
#undef DG_ITEM
#undef DG_PREFETCH
}

#define GAS __attribute__((address_space(1)))
__device__ __forceinline__ unsigned xb_ld(unsigned* p)              { return __hip_atomic_load(p, __ATOMIC_RELAXED, __HIP_MEMORY_SCOPE_AGENT); }
__device__ __forceinline__ unsigned xb_add(unsigned* p, unsigned v) { return __hip_atomic_fetch_add(p, v, __ATOMIC_RELAXED, __HIP_MEMORY_SCOPE_AGENT); }
#define XB_TMO      128
#define XB_XCNT(j)  (256  + 64 * (j))
#define XB_XSUB(j)  (1280 + 64 * (j))
#define XB_XGEN(j)  (2304 + 64 * (j))
#define XB_TOP      3328
#define XB_TOPGEN   3392
#define XCD_BAR_WORDS 3456
#define XB_SPIN_CAP (1u << 18)

__device__ __forceinline__ unsigned xb_xcc_id() { return (unsigned)__builtin_amdgcn_s_getreg((3 << 11) | 20) & 0xFu; }
#define XB_SPIN(cond, bar) do { unsigned _sp = 0; while (cond) { __builtin_amdgcn_s_sleep(1); \
    if ((++_sp & 255u) == 0u) { if (xb_ld(&(bar)[XB_TMO])) break; if (_sp > XB_SPIN_CAP) { atomicAdd(&(bar)[XB_TMO], 1u); break; } } } } while (0)

struct XcdBarrier {
    unsigned* bar; unsigned x;
    volatile LAS unsigned* st;
};

__device__ __forceinline__ XcdBarrier xcd_barrier_post(unsigned* bar, volatile LAS unsigned* st) {
    XcdBarrier b; b.bar = bar; b.x = xb_xcc_id(); b.st = st;
    if (threadIdx.x == 0) st[2] = xb_add(&bar[XB_XCNT(b.x)], 1u);
    return b;
}
__device__ __forceinline__ void xcd_barrier_complete(unsigned* bar, unsigned x, unsigned& nloc, unsigned& nx) {
    const unsigned G = gridDim.x * gridDim.y * gridDim.z;
    unsigned sum, cnt, mine, sp = 0u;
    for (;;) {
        sum = 0u; cnt = 0u; mine = 0u;
#pragma unroll
        for (unsigned j = 0; j < 16; ++j) { const unsigned c = xb_ld(&bar[XB_XCNT(j)]); sum += c; cnt += (c > 0u) ? 1u : 0u; mine = (j == x) ? c : mine; }
        if (sum == G) break;
        __builtin_amdgcn_s_sleep(1);
        if ((++sp & 255u) == 0u) { if (xb_ld(&bar[XB_TMO])) break; if (sp > XB_SPIN_CAP) { atomicAdd(&bar[XB_TMO], 1u); break; } }
    }
    nloc = mine > 0u ? mine : 1u; nx = cnt > 0u ? cnt : 1u;
}

__device__ __forceinline__ void xcd_barrier(const XcdBarrier& b) {
    asm volatile("s_waitcnt vmcnt(0)" ::: "memory");
    __syncthreads();
    if (threadIdx.x == 0) {
        unsigned* bar = b.bar;
        __builtin_amdgcn_s_waitcnt(0);
        unsigned nloc = b.st[0], nx = b.st[1];
        if (nloc == 0u) { xcd_barrier_complete(bar, b.x, nloc, nx); b.st[0] = nloc; b.st[1] = nx; }
        const unsigned old = xb_add(&bar[XB_XSUB(b.x)], 1u);
        const unsigned gen = old / nloc;
        if (old + 1u == (gen + 1u) * nloc) {
            __builtin_amdgcn_fence(__ATOMIC_RELEASE, "agent");
            asm volatile("s_waitcnt vmcnt(0)" ::: "memory");
            const unsigned og = xb_add(&bar[XB_TOP], 1u);
            const unsigned tg = og / nx;
            if (og + 1u == (tg + 1u) * nx) xb_add(&bar[XB_TOPGEN], 1u);
            else XB_SPIN(xb_ld(&bar[XB_TOPGEN]) == tg, bar);
            __builtin_amdgcn_fence(__ATOMIC_ACQUIRE, "agent");
            xb_add(&bar[XB_XGEN(b.x)], 1u);
            asm volatile("s_waitcnt vmcnt(0)" ::: "memory");
        } else {
            XB_SPIN(xb_ld(&bar[XB_XGEN(b.x)]) == gen, bar);
            __builtin_amdgcn_fence(__ATOMIC_ACQUIRE, "agent");
            asm volatile("s_waitcnt vmcnt(0)" ::: "memory");
        }
    }
    __syncthreads();
}

__global__ void __launch_bounds__(512) yoco_fwd(Args a) {
    extern __shared__ __attribute__((aligned(16))) unsigned char lds_raw[];
    LAS unsigned char* lds = (LAS unsigned char*)lds_raw;
    cg::grid_group grid = cg::this_grid();
    if (threadIdx.x < 4) ((volatile LAS unsigned*)(lds + BARW_OFF))[threadIdx.x] = 0u;
    __syncthreads();
    if (blockIdx.x == 0) { unsigned* bz = (unsigned*)(a.ws + WS_BAR); for (int i = threadIdx.x; i < (int)(BAR_BYTES / 4); i += 512) bz[i] = 0u; }
    XcdBarrier xbar; xbar.bar = (unsigned*)(a.ws + WS_BAR); xbar.x = 0; xbar.st = (volatile LAS unsigned*)(lds + BARW_OFF);
    for (int ph = a.ph_lo; ph < a.ph_hi; ++ph) {
        const int L_ = (ph - 1) / 5, sub_ = (ph - 1) % 5; const bool mid = ph > 0 && ph < NPHASE - 1;
        int nrep = 1;
        if ((PROBE == 1 || PROBE == 8) && mid && sub_ == 1 && L_ < 2) nrep = 2;
        if (PROBE == 3 && mid && sub_ == 3) nrep = 2;
        if (PROBE == 4 && mid && sub_ == 0) nrep = 2;
        if (PROBE == 5 && ph == 3) nrep = 2;
        if ((PROBE == 13 || PROBE == 16) && ph == 1) nrep = 2;
        if (PROBE == 14 && ph == 11) nrep = 2;
        if (PROBE == 15 && ph == 16) nrep = 2;
        if (PROBE == 6 && ph == 0) nrep = 2;
        for (int rep = 0; rep < nrep; ++rep) {
        int tid = threadIdx.x; asm volatile("" : "+v"(tid));
        int bid = blockIdx.x, G = gridDim.x; asm volatile("" : "+s"(bid), "+s"(G));
        const int lane = tid & 63, wave = __builtin_amdgcn_readfirstlane(tid >> 6), gw = bid * 8 + wave, ngw = G * 8;
        ArgsP ap = (ArgsP)__builtin_amdgcn_kernarg_segment_ptr(); asm volatile("" : "+s"(ap));
        unsigned char* ws = ap->ws;
        float* ssqA = (float*)(ws + WS_SSQ); float* ssqB = ssqA; const float* rope = (const float*)(ws + WS_ROPE);
        bf16_t* hb = (bf16_t*)(ws + WS_HB); bf16_t* qo = (bf16_t*)(ws + WS_QO); bf16_t* kb = (bf16_t*)(ws + WS_K); bf16_t* vt = (bf16_t*)(ws + WS_VT); bf16_t* act = (bf16_t*)(ws + WS_ACT);
        bf16_t* odst = (rep + 1 < nrep) ? act : qo;
        if (PROBE == 7 && rep == 0 && ph > 0) grid.sync();
        if (ph == 0) prologue(ap, lds, gw, ngw, wave, lane);
        else if (ph == NPHASE - 1) final_norm(ap, gw, ngw, lane);
        else {
            const int L = (ph - 1) / 5, sub = (ph - 1) % 5;
            if (sub == 0) {
                const bf16_t* W = (L < 2) ? (const bf16_t*)(ws + WS_WQKV_A + L * SZ_WQKV) : (L == 2 ? (const bf16_t*)(ws + WS_WB2) : (const bf16_t*)(ws + WS_WB3));
                const int N = (L == 3) ? 1024 : 3072;
                pg8::Gemm g{hb, W, MTOK, N, DM}; pg8::StaticOrder S; S.init(MTOK, N, G, bid);
                if (L < 2) { pg8::EpiQKV<0> E{qo, kb, vt, ssqB, rope}; pg8::gemm_phase<pg8::EpiQKV<0>, pg8::StaticOrder, true, true>(lds, g, S, E); }
                else { pg8::EpiQKV<1> E{qo, kb, vt, ssqB, rope}; pg8::gemm_phase<pg8::EpiQKV<1>, pg8::StaticOrder, true, true>(lds, g, S, E); }
            } else if (sub == 1) {
                if (L < 2) {
                    sb_groups(qo, kb, vt, odst, bid, G, tid, lds);
                } else {
                    bf16_t* x1 = act; float* lse = (float*)(ws + WS_ACT + 128 * MiB);
                    bool xo = (G == 256); { unsigned* bw = (unsigned*)(ws + WS_BAR);
#pragma unroll
                        for (int j = 0; j < 16; ++j) xo = xo && (xb_ld(&bw[XB_XCNT(j)]) == (j < 8 ? 32u : 0u)); }
                    const int myx = (int)xb_xcc_id(), myr = (int)((volatile LAS unsigned*)(lds + BARW_OFF))[2];
                    const int wpx = xo ? 256 : ngw, vw = xo ? myr * 8 + wave : gw, xcd = xo ? myx : 0, nun = xo ? 4096 : 32768;
                    dil_groups0(qo, kb, vt, x1, lse, xo, xcd, myr, bid, G, tid, lds);
                    if (PROBE == 9 || PROBE == 10) { int t3 = threadIdx.x; asm volatile("" : "+v"(t3)); const int lane3 = t3 & 63;
                        for (int u = vw; u < nun; u += wpx) { const int bh = xcd * 32 + (u >> 7), rem = u & 127; dil_unit<0>(qo, kb, vt, qo, x1 + 136 * MiB / 2, lse + 66 * MiB, bh, 0, rem, lane3, lds + SCR_OFF + wave * SCR_BYTES, PROBE == 9 ? 64 : 2); } }
                    if (PROBE == 12) { int t3 = threadIdx.x; asm volatile("" : "+v"(t3));
                        if (xo) { for (int u = myr; u < 512; u += 32) dil_group0(qo, kb, vt, x1 + 136 * MiB / 2, lse + 66 * MiB, xcd * 32 + (u >> 4), u & 15, t3, lds); }
                        else { for (int u = bid; u < 4096; u += G) dil_group0(qo, kb, vt, x1 + 136 * MiB / 2, lse + 66 * MiB, u >> 4, u & 15, t3, lds); } }
                    xcd_barrier(xbar);
                    if (PROBE == 11) { int t4 = threadIdx.x; asm volatile("" : "+v"(t4)); const int lane4 = t4 & 63;
                        for (int u = vw; u < nun; u += wpx) { const int bh = xcd * 32 + (u >> 7), rem = u & 127; dil_unit<1>(qo, kb, vt, x1 + 136 * MiB / 2, x1, lse, bh, rem & 15, rem >> 4, lane4, lds + SCR_OFF + wave * SCR_BYTES); } }
                    { int t2 = threadIdx.x; asm volatile("" : "+v"(t2)); const int lane2 = t2 & 63;
                    for (int u = vw; u < nun; u += wpx) { const int bh = xcd * 32 + (u >> 7), rem = u & 127; dil_unit<1>(qo, kb, vt, qo, x1, lse, bh, rem & 15, rem >> 4, lane2, lds + SCR_OFF + wave * SCR_BYTES); } }
                }
            } else if (sub == 2) {
                const bf16_t* W = (L < 2) ? (const bf16_t*)(ws + WS_WO_A + L * SZ_WSQ) : (const bf16_t*)(ws + WS_WO_B + (L - 2) * SZ_WSQ);
                pg8::Gemm g{qo, W, MTOK, DM, DM}; pg8::StaticOrder S; S.init(MTOK, DM, G, bid);
                pg8::EpiRes E{hb, ssqA};
                pg8::gemm_phase<pg8::EpiRes, pg8::StaticOrder, true, true>(lds, g, S, E);
            } else if (sub == 3) {
                pg8::Gemm g{hb, (const bf16_t*)(ws + WS_WGU + L * SZ_WGU), MTOK, 2 * DFF, DM}; pg8::StaticOrder S; S.init(MTOK, 2 * DFF, G, bid);
                pg8::EpiSwiGLU E{act, ssqA};
                pg8::gemm_phase<pg8::EpiSwiGLU, pg8::StaticOrder, true, true>(lds, g, S, E);
            } else {
                pg8::Gemm g{act, (const bf16_t*)(ws + WS_WDN + L * SZ_WDN), MTOK, DM, DFF}; pg8::StaticOrder S; S.init(MTOK, DM, G, bid);
                pg8::EpiRes E{hb, ssqB};
                pg8::gemm_phase<pg8::EpiRes, pg8::StaticOrder, true, true>(lds, g, S, E);
            }
        }
        }
        if (ph + 1 < a.ph_hi) { if (ph == a.ph_lo) { grid.sync(); xbar = xcd_barrier_post((unsigned*)(a.ws + WS_BAR), (volatile LAS unsigned*)(lds + BARW_OFF)); } else xcd_barrier(xbar); }
    }
}

#ifndef N_LAUNCHES
#define N_LAUNCHES 1
#endif
extern "C" void kernel_launch(void* const* d_in, const int* in_sizes, int n_in, void* d_out, int out_size, void* d_ws, size_t ws_size, hipStream_t stream) {
    static int grid = 0;
    if (grid == 0) {
        if (n_in != 13 || in_sizes[0] != MTOK * DM || out_size != MTOK * DM || ws_size < WS_END) { fprintf(stderr, "kernel_launch: unexpected shapes / workspace (n_in %d, ws %zu)\n", n_in, ws_size); grid = -1; return; }
        int dev = 0, cus = 0, per_cu = 0;
        (void)hipGetDevice(&dev); (void)hipDeviceGetAttribute(&cus, hipDeviceAttributeMultiprocessorCount, dev);
        if (hipFuncSetAttribute((const void*)yoco_fwd, hipFuncAttributeMaxDynamicSharedMemorySize, LDS_BYTES) != hipSuccess) { fprintf(stderr, "kernel_launch: hipFuncSetAttribute failed\n"); grid = -1; return; }
        if (hipOccupancyMaxActiveBlocksPerMultiprocessor(&per_cu, (const void*)yoco_fwd, 512, LDS_BYTES) != hipSuccess || per_cu < 1) per_cu = 1;
        (void)hipGetLastError();
        grid = cus * per_cu;
        if (grid > 256) grid = 256;
    }
    if (grid < 0) return;
    Args a{};
    for (int i = 0; i < 13; ++i) a.in[i] = (const float*)d_in[i];
    a.out = (float*)d_out; a.ws = (unsigned char*)d_ws;
    if (N_LAUNCHES == 1) {
        a.ph_lo = 0; a.ph_hi = NPHASE;
        void* kargs[] = {&a};
        hipError_t e = hipLaunchCooperativeKernel((const void*)yoco_fwd, dim3(grid), dim3(512), kargs, LDS_BYTES, stream);
        if (e != hipSuccess) fprintf(stderr, "cooperative launch failed: %s (grid %d)\n", hipGetErrorString(e), grid);
    } else {
        for (int ph = 0; ph < NPHASE; ++ph) { a.ph_lo = ph; a.ph_hi = ph + 1; hipLaunchKernelGGL(yoco_fwd, dim3(grid), dim3(512), LDS_BYTES, stream, a); }
    }
}
```

```cpp
#include <hip/hip_runtime.h>
#include <hip/hip_cooperative_groups.h>
#include <cstdio>
#include <cstdint>
namespace cg = cooperative_groups;
namespace pg8 {
#define PG8_LAS __attribute__((address_space(3)))
typedef unsigned short bf16_t;
typedef short bf16x8 __attribute__((ext_vector_type(8)));
typedef float f32x4 __attribute__((ext_vector_type(4)));
typedef unsigned u32x4 __attribute__((ext_vector_type(4)));
constexpr int BM = 256, BK = 64, HALF = 128, HTB = HALF * BK * 2  , STAGE_BYTES = 8 * HTB, NXCD = 8, WGM = 8;

__host__ __device__ __forceinline__ int lds_byte(int r, int c) { const int st = (r >> 4) * 2 + (c >> 5), rr = r & 15, cc = c & 31, ob = rr * 64 + cc * 2; return st * 1024 + (ob ^ (((ob >> 9) & 1) << 5)); }
__host__ __device__ __forceinline__ void stage_rc(int b, int& R, int& C) { const int st = b / 1024, sb = b % 1024, swz = sb ^ (((sb >> 9) & 1) << 5); R = (st >> 1) * 16 + swz / 64; C = (st & 1) * 32 + (swz % 64) / 2; }
__host__ __device__ __forceinline__ int perm32(int rho) { const int n = rho >> 4, i = rho & 15; return 8 * (i >> 2) + 4 * n + (i & 3); }

struct Unit { int pm, pn; };
struct Gemm { const bf16_t* A; const bf16_t* Bt; int M, N, K; };

struct StaticOrder {
    int nM, nN, nwg, G, c;
    __host__ __device__ void init(int M, int N, int G_, int c_) { nM = M / BM; nN = N / BM; nwg = nM * nN; G = G_; c = c_; }
    __host__ __device__ bool next(int i, Unit& u) const {
        const long L = (long)i * G + c; if (L >= nwg) return false;
        int wgid = (int)L; { const int q = nwg / NXCD, r = nwg % NXCD, xcd = wgid % NXCD, off = wgid / NXCD; wgid = (xcd < r ? xcd * (q + 1) : r * (q + 1) + (xcd - r) * q) + off; }
        const int nig = WGM * nN, gid = wgid / nig, fm = gid * WGM, gsz = (nM - fm) < WGM ? (nM - fm) : WGM;
        u.pm = fm + ((wgid % nig) % gsz); u.pn = (wgid % nig) / gsz; return true;
    }
    __device__ __forceinline__ void a_ready(const Unit&) const {}
    __device__ __forceinline__ void done(const Unit&) const {}
};

typedef unsigned u32x2 __attribute__((ext_vector_type(2)));
__device__ __forceinline__ unsigned cvt_pk_bf16(float lo, float hi) { unsigned r; asm volatile("v_cvt_pk_bf16_f32 %0, %1, %2" : "=v"(r) : "v"(lo), "v"(hi)); return r; }
constexpr float NORM_EPS = 1e-6f;
constexpr float QSCALE = 0.125f * 1.4426950408889634f;
__device__ __forceinline__ float row_rstd(const float* ssq, size_t row) {
    const f32x4* p = (const f32x4*)(ssq + row * 16); const f32x4 a = p[0], b = p[1], c = p[2], d = p[3];
    const float t = ((a[0] + a[1]) + (a[2] + a[3])) + ((b[0] + b[1]) + (b[2] + b[3])) + ((c[0] + c[1]) + (c[2] + c[3])) + ((d[0] + d[1]) + (d[2] + d[3]));
    return __builtin_amdgcn_rsqf(t * (1.0f / 1024.0f) + NORM_EPS);
}
__device__ __forceinline__ float row_ssq4(const float* ssq, size_t row, int fq) { const f32x4 a = ((const f32x4*)(ssq + row * 16))[fq]; return (a[0] + a[1]) + (a[2] + a[3]); }
__device__ __forceinline__ float rstd_fin(float t) { t += __shfl_xor(t, 16); t += __shfl_xor(t, 32); return __builtin_amdgcn_rsqf(t * (1.0f / 1024.0f) + NORM_EPS); }
template <int VMODE> struct EpiQKV {
    static constexpr bool PERM = true, AFTER_DRAIN = false, PERM_A = (VMODE == 0); static constexpr int vmode = VMODE, rope_on = VMODE, RM = PERM_A ? 1 : 16, RF = PERM_A ? 4 : 1;
    bf16_t* Q; bf16_t* Kb; bf16_t* Vt; const float* ssq; const float* rope;
    __device__ __forceinline__ void operator()(const f32x4 (&acc)[2][2][4][2], const Unit& u, int wr, int wc, int fr, int fq) const {
        asm volatile("" : "+v"(fr), "+v"(fq));
        const int type = u.pn >> 2, head = (u.pn & 3) * 4 + wc;
        const int b = u.pm >> 4, s0 = (u.pm & 15) * 256 + wr * 64 + RF * fr;
        const size_t row0 = (size_t)u.pm * 256 + wr * 64 + RF * fr;
        if (type < 2) {
            bf16_t* base = (type == 0) ? Q : Kb; const float sc = (type == 0) ? QSCALE : 1.0f;
            float rs[8];
#pragma unroll
            for (int t = 0; t < 8; ++t) rs[t] = row_ssq4(ssq, row0 + (t >> 2) * 128 + (t & 3) * RM, fq);
#pragma unroll
            for (int t = 0; t < 8; ++t) rs[t] = rstd_fin(rs[t]) * sc;
            f32x4 cs[2][2], sn[2][2];
            if (rope_on) { const float* rp = rope + (size_t)s0 * 64 + 8 * fq;
#pragma unroll
                for (int n = 0; n < 2; ++n) { cs[0][n] = *(const f32x4*)(rp + 4 * n); sn[0][n] = *(const f32x4*)(rp + 32 + 4 * n); } }
#pragma unroll
            for (int t = 0; t < 8; ++t) {
                const int ai = t >> 2, m = t & 3, cur = t & 1, nxt = cur ^ 1;
                const size_t row = row0 + ai * 128 + m * RM; const int s = s0 + ai * 128 + m * RM; const float f = rs[t];
                if (rope_on && t < 7) { const float* rp = rope + (size_t)(s0 + ((t + 1) >> 2) * 128 + ((t + 1) & 3) * RM) * 64 + 8 * fq;
#pragma unroll
                    for (int n = 0; n < 2; ++n) { cs[nxt][n] = *(const f32x4*)(rp + 4 * n); sn[nxt][n] = *(const f32x4*)(rp + 32 + 4 * n); } }
                f32x4 lo[2], hi[2];
#pragma unroll
                for (int n = 0; n < 2; ++n) { lo[n] = acc[ai][0][m][n] * f; hi[n] = acc[ai][1][m][n] * f; }
                if (rope_on) {
#pragma unroll
                    for (int n = 0; n < 2; ++n) { const f32x4 a1 = lo[n], a2 = hi[n]; lo[n] = a1 * cs[cur][n] - a2 * sn[cur][n]; hi[n] = a2 * cs[cur][n] + a1 * sn[cur][n]; } }
                bf16_t* dst; int hoff;
                if (type == 1 && vmode == 1) { dst = base + ((size_t)((b * 16 + head) * 16 + fr) * 32 + (u.pm & 15) * 2 + ai) * 512 + (fq * 8 + 4 * wr + m) * 8; hoff = 256; }
                else if (type == 1) {
                    const int kk = s & 31, mrow = 8 * ((kk >> 2) & 3) + 4 * (kk >> 4) + (kk & 3);
                    dst = base + ((size_t)(b * 16 + head) * 128 + (s >> 5)) * 2048 + (fq >> 1) * 512 + ((fq & 1) * 32 + mrow) * 8; hoff = 1024; }
                else { dst = base + row * 1024 + head * 64 + 8 * fq; hoff = 32; }
                u32x4 w; w.x = cvt_pk_bf16(lo[0][0], lo[0][1]); w.y = cvt_pk_bf16(lo[0][2], lo[0][3]); w.z = cvt_pk_bf16(lo[1][0], lo[1][1]); w.w = cvt_pk_bf16(lo[1][2], lo[1][3]);
                *(u32x4*)dst = w;
                w.x = cvt_pk_bf16(hi[0][0], hi[0][1]); w.y = cvt_pk_bf16(hi[0][2], hi[0][3]); w.z = cvt_pk_bf16(hi[1][0], hi[1][1]); w.w = cvt_pk_bf16(hi[1][2], hi[1][3]);
                *(u32x4*)(dst + hoff) = w;
                if (rope_on) asm volatile("" ::: "memory");
            }
        } else {
            bf16_t* vb = Vt + ((size_t)(b * 16 + head) * 64) * 4096;
            float rstd[2][4];
#pragma unroll
            for (int ai = 0; ai < 2; ++ai)
#pragma unroll
                for (int m = 0; m < 4; ++m) rstd[ai][m] = row_ssq4(ssq, row0 + ai * 128 + m * RM, fq);
#pragma unroll
            for (int ai = 0; ai < 2; ++ai)
#pragma unroll
                for (int m = 0; m < 4; ++m) rstd[ai][m] = rstd_fin(rstd[ai][m]);
#pragma unroll
            for (int bj = 0; bj < 2; ++bj)
#pragma unroll
                for (int n = 0; n < 2; ++n)
#pragma unroll
                    for (int i = 0; i < 4; ++i) {
#pragma unroll
                        for (int ai = 0; ai < 2; ++ai) {
                            const float v0 = acc[ai][bj][0][n][i] * rstd[ai][0], v1 = acc[ai][bj][1][n][i] * rstd[ai][1], v2 = acc[ai][bj][2][n][i] * rstd[ai][2], v3 = acc[ai][bj][3][n][i] * rstd[ai][3];
                            const unsigned p01 = cvt_pk_bf16(v0, v1), p23 = cvt_pk_bf16(v2, v3);
                            if (vmode == 0) {
                                u32x2 w; w.x = p01; w.y = p23;
                                *(u32x2*)(vb + (size_t)((u.pm & 15) * 8 + 4 * ai + 2 * wr + (fr >> 3)) * 2048 + ((bj * 2 + ((fr >> 1) & 1)) * 64 + ((fr >> 2) & 1) * 32 + 8 * fq + 4 * n + i) * 8 + 4 * (fr & 1)) = w; }
                            else { u32x2 w; w.x = p01; w.y = p23;
                                *(u32x2*)(vb + ((size_t)fr * 32 + (u.pm & 15) * 2 + ai) * 512 + (32 * bj + 8 * fq + 4 * n + i) * 8 + wr * 4) = w; }
                        }
                    }
        }
    }
};
struct EpiRes {
    static constexpr bool PERM = true, AFTER_DRAIN = false, PERM_A = false;
    bf16_t* hb; float* ssq;
    __device__ __forceinline__ void operator()(const f32x4 (&acc)[2][2][4][2], const Unit& u, int wr, int wc, int fr, int fq) const {
        asm volatile("" : "+v"(fr), "+v"(fq));
        const int c0 = u.pn * 256 + wc * 32 + 8 * fq; const size_t row0 = (size_t)u.pm * 256 + wr * 64 + fr;
        u32x4 old[2][2];
#pragma unroll
        for (int bj = 0; bj < 2; ++bj) old[0][bj] = *(const u32x4*)(hb + row0 * 1024 + c0 + bj * 128);
#pragma unroll
        for (int t = 0; t < 8; ++t) {
            const int ai = t >> 2, m = t & 3, cur = t & 1, nxt = cur ^ 1;
            const size_t row = row0 + ai * 128 + m * 16; float ss = 0.f;
            if (t < 7) { const size_t rn = row0 + ((t + 1) >> 2) * 128 + ((t + 1) & 3) * 16;
#pragma unroll
                for (int bj = 0; bj < 2; ++bj) old[nxt][bj] = *(const u32x4*)(hb + rn * 1024 + c0 + bj * 128); }
#pragma unroll
            for (int bj = 0; bj < 2; ++bj) { const size_t off = row * 1024 + c0 + bj * 128; const u32x4 o = old[cur][bj];
                f32x4 h0 = acc[ai][bj][m][0], h1 = acc[ai][bj][m][1];
                h0[0] += __uint_as_float(o.x << 16); h0[1] += __uint_as_float(o.x & 0xffff0000u); h0[2] += __uint_as_float(o.y << 16); h0[3] += __uint_as_float(o.y & 0xffff0000u);
                h1[0] += __uint_as_float(o.z << 16); h1[1] += __uint_as_float(o.z & 0xffff0000u); h1[2] += __uint_as_float(o.w << 16); h1[3] += __uint_as_float(o.w & 0xffff0000u);
                u32x4 w; w.x = cvt_pk_bf16(h0[0], h0[1]); w.y = cvt_pk_bf16(h0[2], h0[3]); w.z = cvt_pk_bf16(h1[0], h1[1]); w.w = cvt_pk_bf16(h1[2], h1[3]); *(u32x4*)(hb + off) = w;
                ss += ((h0[0] * h0[0] + h0[1] * h0[1]) + (h0[2] * h0[2] + h0[3] * h0[3])) + ((h1[0] * h1[0] + h1[1] * h1[1]) + (h1[2] * h1[2] + h1[3] * h1[3])); }
            ss += __shfl_xor(ss, 16); ss += __shfl_xor(ss, 32);
            if (fq == 0) ssq[row * 16 + u.pn * 4 + wc] = ss;
            asm volatile("" ::: "memory");
        }
    }
};
struct EpiSwiGLU {
    static constexpr bool PERM = true, AFTER_DRAIN = false, PERM_A = false;
    bf16_t* act; const float* ssq;
    __device__ __forceinline__ void operator()(const f32x4 (&acc)[2][2][4][2], const Unit& u, int wr, int wc, int fr, int fq) const {
        asm volatile("" : "+v"(fr), "+v"(fq));
        const int col0 = u.pn * 128 + wc * 32 + 8 * fq; const size_t row0 = (size_t)u.pm * 256 + wr * 64 + fr;
        float rsv[8];
#pragma unroll
        for (int t = 0; t < 8; ++t) rsv[t] = row_ssq4(ssq, row0 + (t >> 2) * 128 + (t & 3) * 16, fq);
#pragma unroll
        for (int t = 0; t < 8; ++t) rsv[t] = rstd_fin(rsv[t]);
#pragma unroll
        for (int ai = 0; ai < 2; ++ai)
#pragma unroll
            for (int m = 0; m < 4; ++m) {
                const size_t row = row0 + ai * 128 + m * 16; const float rs = rsv[ai * 4 + m];
                float o[8];
#pragma unroll
                for (int n = 0; n < 2; ++n)
#pragma unroll
                    for (int i = 0; i < 4; ++i) { const float g = acc[ai][0][m][n][i] * rs, up = acc[ai][1][m][n][i] * rs;
                        const float sg = __builtin_amdgcn_rcpf(1.0f + __builtin_amdgcn_exp2f(-1.4426950408889634f * g)); o[4 * n + i] = g * sg * up; }
                u32x4 w; w.x = cvt_pk_bf16(o[0], o[1]); w.y = cvt_pk_bf16(o[2], o[3]); w.z = cvt_pk_bf16(o[4], o[5]); w.w = cvt_pk_bf16(o[6], o[7]);
                __builtin_nontemporal_store(w, (u32x4*)(act + row * 2816 + col0));
            }
    }
};

template <class Epi, class Sched, bool ALIGN_EPI = false, bool SP2 = false>
__device__ __forceinline__ void gemm_phase(PG8_LAS unsigned char* lds, const Gemm g, const Sched& S, const Epi& E) {
    int tid_l = threadIdx.x; asm volatile("" : "+v"(tid_l)); const int tid = tid_l, wid = __builtin_amdgcn_readfirstlane(tid >> 6), lane = tid & 63, wr = wid >> 2, wc = wid & 3, fr = lane & 15, fq = lane >> 4;
    const int K = g.K, nt = K / BK;
    unsigned voffA[2], voffB[2];
#pragma unroll
    for (int i = 0; i < 2; ++i) { int R, C; stage_rc(tid * 16 + i * 8192, R, C); const int Rb = Epi::PERM ? ((R & ~31) + perm32(R & 31)) : R;
        const int Ra = Epi::PERM_A ? ((R & ~63) + 4 * (R & 15) + ((R >> 4) & 3)) : R;
        voffA[i] = (unsigned)(Ra * K + C) * 2u; voffB[i] = (unsigned)(Rb * K + C) * 2u; }
    const size_t kstep = (size_t)(BK * 2);
    const size_t hstep = (size_t)HALF * K * 2;
    const size_t tstep = 2 * hstep;
    const unsigned ldsw = (unsigned)wid * 1024u;
    const int aoff = lds_byte(wr * 64 + fr, fq * 8), boff = lds_byte(wc * 32 + fr, fq * 8);
#define PG8_SA(b, h) (((b) * 2 + (h)) * HTB)
#define PG8_SB(b, h) ((4 + (b) * 2 + (h)) * HTB)
#define PG8_STAGE(bufoff, gbase, voff) do { _Pragma("unroll") for (int _i = 0; _i < 2; ++_i) \
        __builtin_amdgcn_global_load_lds((const unsigned*)((const char*)(gbase) + (voff)[_i]), (PG8_LAS unsigned*)(lds + (bufoff) + ldsw + _i * 8192), 16, 0, 0); } while (0)
#define PG8_LDA(dst, b, h) do { _Pragma("unroll") for (int m = 0; m < 4; ++m) _Pragma("unroll") for (int k = 0; k < 2; ++k) dst[m][k] = *(const PG8_LAS bf16x8*)(lds + PG8_SA(b, h) + aoff + m * 2048 + k * 1024); } while (0)
#define PG8_LDB(dst, b, h) do { _Pragma("unroll") for (int n = 0; n < 2; ++n) _Pragma("unroll") for (int k = 0; k < 2; ++k) dst[n][k] = *(const PG8_LAS bf16x8*)(lds + PG8_SB(b, h) + boff + n * 2048 + k * 1024); } while (0)
#define PG8_MMA(ai, bj, At, Bt) do { __builtin_amdgcn_s_setprio(1); _Pragma("unroll") for (int m = 0; m < 4; ++m) _Pragma("unroll") for (int n = 0; n < 2; ++n) _Pragma("unroll") for (int k = 0; k < 2; ++k) \
        acc[ai][bj][m][n] = __builtin_amdgcn_mfma_f32_16x16x32_bf16(Bt[n][k], At[m][k], acc[ai][bj][m][n], 0, 0, 0); __builtin_amdgcn_s_setprio(0); } while (0)
#define PG8_WAIT_V(n) asm volatile("s_waitcnt vmcnt(" #n ")" ::: "memory")
#define PG8_WAIT_L(n) asm volatile("s_waitcnt lgkmcnt(" #n ")" ::: "memory")
#define PG8_BAR __builtin_amdgcn_s_barrier()
#define PG8_SCHED __builtin_amdgcn_sched_barrier(0)
    Unit cur, nxt; int ui = 0;
    if (!S.next(0, cur)) return;
    f32x4 acc[2][2][4][2];
#pragma unroll
    for (int a = 0; a < 2; ++a)
#pragma unroll
        for (int b = 0; b < 2; ++b)
#pragma unroll
            for (int m = 0; m < 4; ++m)
#pragma unroll
                for (int n = 0; n < 2; ++n) acc[a][b][m][n] = (f32x4){0.f, 0.f, 0.f, 0.f};
    bf16x8 At[4][2], B0[2][2], B1[2][2];
    const char* cA = (const char*)g.A + (size_t)cur.pm * tstep; const char* cB = (const char*)g.Bt + (size_t)cur.pn * tstep;
    S.a_ready(cur);
    if constexpr (SP2) {
        PG8_STAGE(PG8_SB(0, 0), cB, voffB); PG8_STAGE(PG8_SB(0, 1), cB + hstep, voffB); PG8_STAGE(PG8_SA(0, 0), cA, voffA); PG8_STAGE(PG8_SA(0, 1), cA + hstep, voffA);
        if (wr == 1) PG8_BAR;
        PG8_WAIT_V(2); PG8_BAR;
        PG8_STAGE(PG8_SB(1, 0), cB + kstep, voffB); PG8_STAGE(PG8_SA(1, 0), cA + kstep, voffA); PG8_STAGE(PG8_SB(1, 1), cB + hstep + kstep, voffB);
        PG8_WAIT_V(6); PG8_BAR;
    } else {
        PG8_STAGE(PG8_SB(0, 0), cB, voffB); PG8_STAGE(PG8_SA(0, 0), cA, voffA); PG8_STAGE(PG8_SB(0, 1), cB + hstep, voffB); PG8_STAGE(PG8_SA(0, 1), cA + hstep, voffA);
        if (wr == 1) PG8_BAR;
        PG8_WAIT_V(4); PG8_BAR;
        PG8_STAGE(PG8_SB(1, 0), cB + kstep, voffB); PG8_STAGE(PG8_SA(1, 0), cA + kstep, voffA); PG8_STAGE(PG8_SB(1, 1), cB + hstep + kstep, voffB);
        PG8_WAIT_V(6); PG8_BAR;
    }
    for (;;) {
        const bool has_next = S.next(ui + 1, nxt);
        const char* nA = has_next ? (const char*)g.A + (size_t)nxt.pm * tstep : cA; const char* nB = has_next ? (const char*)g.Bt + (size_t)nxt.pn * tstep : cB;
        for (int t = 0; t < nt; t += 2) {
            const bool last = (t == nt - 2);
            const char* a1 = cA + (size_t)(t + 1) * kstep;
            const char* a2 = last ? nA : cA + (size_t)(t + 2) * kstep; const char* b2 = last ? nB : cB + (size_t)(t + 2) * kstep;
            const char* a3 = a2 + kstep; const char* b3 = b2 + kstep;
            if (last && has_next) S.a_ready(nxt);
            if constexpr (SP2) {
            PG8_LDB(B0, 0, 0); PG8_LDB(B1, 0, 1); PG8_SCHED; PG8_LDA(At, 0, 0); PG8_STAGE(PG8_SA(1, 1), a1 + hstep, voffA);
            PG8_WAIT_V(8); PG8_WAIT_L(0); PG8_BAR; PG8_MMA(0, 0, At, B0); PG8_MMA(0, 1, At, B1); PG8_BAR; PG8_SCHED;
            PG8_LDA(At, 0, 1); PG8_STAGE(PG8_SB(0, 0), b2, voffB); PG8_STAGE(PG8_SB(0, 1), b2 + hstep, voffB); PG8_STAGE(PG8_SA(0, 0), a2, voffA);
            PG8_WAIT_V(8); PG8_WAIT_L(0); PG8_BAR; PG8_MMA(1, 0, At, B0); PG8_MMA(1, 1, At, B1); PG8_BAR; PG8_SCHED;
            PG8_LDB(B0, 1, 0); PG8_LDB(B1, 1, 1); PG8_SCHED; PG8_LDA(At, 1, 0); PG8_STAGE(PG8_SA(0, 1), a2 + hstep, voffA);
            PG8_WAIT_V(8); PG8_WAIT_L(0); PG8_BAR; PG8_MMA(0, 0, At, B0); PG8_MMA(0, 1, At, B1); PG8_BAR; PG8_SCHED;
            PG8_LDA(At, 1, 1); PG8_STAGE(PG8_SB(1, 0), b3, voffB); PG8_STAGE(PG8_SB(1, 1), b3 + hstep, voffB); PG8_STAGE(PG8_SA(1, 0), a3, voffA);
            PG8_WAIT_V(8); PG8_WAIT_L(0); PG8_BAR; PG8_MMA(1, 0, At, B0); PG8_MMA(1, 1, At, B1); PG8_BAR; PG8_SCHED;
            } else {
            PG8_LDB(B0, 0, 0); PG8_SCHED; PG8_LDA(At, 0, 0); PG8_STAGE(PG8_SA(1, 1), a1 + hstep, voffA);
            PG8_WAIT_L(8); PG8_BAR; PG8_WAIT_L(0); PG8_MMA(0, 0, At, B0); PG8_BAR; PG8_SCHED;
            PG8_LDB(B1, 0, 1); PG8_STAGE(PG8_SB(0, 0), b2, voffB);
            PG8_BAR; PG8_WAIT_L(0); PG8_MMA(0, 1, At, B1); PG8_BAR;
            PG8_LDA(At, 0, 1); PG8_STAGE(PG8_SA(0, 0), a2, voffA);
            PG8_BAR; PG8_WAIT_L(0); PG8_MMA(1, 0, At, B0); PG8_BAR; PG8_SCHED;
            PG8_STAGE(PG8_SB(0, 1), b2 + hstep, voffB);
            PG8_WAIT_V(6); PG8_BAR; PG8_MMA(1, 1, At, B1); PG8_BAR;
            PG8_LDB(B0, 1, 0); PG8_SCHED; PG8_LDA(At, 1, 0); PG8_STAGE(PG8_SA(0, 1), a2 + hstep, voffA);
            PG8_WAIT_L(8); PG8_BAR; PG8_WAIT_L(0); PG8_MMA(0, 0, At, B0); PG8_BAR; PG8_SCHED;
            PG8_LDB(B1, 1, 1); PG8_STAGE(PG8_SB(1, 0), b3, voffB);
            PG8_BAR; PG8_WAIT_L(0); PG8_MMA(0, 1, At, B1); PG8_BAR;
            PG8_LDA(At, 1, 1); PG8_STAGE(PG8_SA(1, 0), a3, voffA);
            PG8_BAR; PG8_WAIT_L(0); PG8_MMA(1, 0, At, B0); PG8_BAR; PG8_SCHED;
            PG8_STAGE(PG8_SB(1, 1), b3 + hstep, voffB);
            PG8_WAIT_V(6); PG8_BAR; PG8_MMA(1, 1, At, B1); PG8_BAR;
            }
        }
        if constexpr (ALIGN_EPI) { if (wr == 0) PG8_BAR; }
        if constexpr (!Epi::AFTER_DRAIN) { E(acc, cur, wr, wc, fr, fq); S.done(cur); }
        if (!has_next) break;
#pragma unroll
        for (int a = 0; a < 2; ++a)
#pragma unroll
            for (int b = 0; b < 2; ++b)
#pragma unroll
                for (int m = 0; m < 4; ++m)
#pragma unroll
                    for (int n = 0; n < 2; ++n) acc[a][b][m][n] = (f32x4){0.f, 0.f, 0.f, 0.f};
        cur = nxt; cA = nA; cB = nB; ++ui;
        if constexpr (ALIGN_EPI) { if (wr == 1) PG8_BAR; }
    }
    PG8_WAIT_V(0);
    if constexpr (!ALIGN_EPI) { if (wr == 0) PG8_BAR; }
    PG8_BAR;
    if constexpr (Epi::AFTER_DRAIN) { E.fused(acc, cur, wr, wc, fr, fq, lds, wid, lane); S.done(cur); }
#undef PG8_SA
#undef PG8_SB
#undef PG8_STAGE
#undef PG8_LDA
#undef PG8_LDB
#undef PG8_MMA
#undef PG8_WAIT_V
#undef PG8_WAIT_L
#undef PG8_BAR
#undef PG8_SCHED
}
}
using pg8::bf16_t; using pg8::bf16x8; using pg8::f32x4; using pg8::u32x4; using pg8::u32x2; using pg8::cvt_pk_bf16;
typedef float f32x16 __attribute__((ext_vector_type(16)));
#define LAS __attribute__((address_space(3)))
constexpr int DM = 1024, NBATCH = 16, SEQ = 4096, NH = 16, HD = 64, DFF = 2816, MTOK = NBATCH * SEQ, DEPTH = 4;
constexpr size_t MiB = 1u << 20;
constexpr size_t WS_SSQ = 0, WS_ROPE = 4 * MiB, WS_BAR = 6 * MiB, BAR_BYTES = 16384;
constexpr size_t WS_WQKV_A = 8 * MiB, WS_WO_A = 20 * MiB, WS_WB2 = 24 * MiB, WS_WB3 = 30 * MiB, WS_WO_B = 32 * MiB, WS_WGU = 36 * MiB, WS_WDN = 80 * MiB;
constexpr size_t WS_HB = 104 * MiB, WS_QO = 232 * MiB, WS_K = 360 * MiB, WS_VT = 488 * MiB, WS_ACT = 616 * MiB, WS_END = 968 * MiB;
constexpr size_t SZ_WQKV = (size_t)3072 * 1024 * 2, SZ_WSQ = (size_t)1024 * 1024 * 2, SZ_WGU = (size_t)5632 * 1024 * 2, SZ_WDN = (size_t)1024 * 2816 * 2;
constexpr int BARW_OFF = 155584;
constexpr int LDS_BYTES = 155648;
constexpr int NPHASE = 22;
#ifndef PROBE
#define PROBE 0
#endif

struct TJob { const float* src; const float* gain; bf16_t* dst; int ld, col0, ncols, K, dst_row0, map; };
struct Args { const float* in[13]; float* out; unsigned char* ws; int ph_lo, ph_hi; };
typedef const __attribute__((address_space(4))) Args* ArgsP;
constexpr int NJOBS = 21;
__device__ __forceinline__ int job_items(int j) { if (j < 6) return (j % 3 == 0) ? 16 * 96 : 16 * 32; if (j == 7) return 16 * 64; if (j < 9) return 16 * 32; return ((j - 9) % 3 == 2) ? 44 * 32 : 16 * 88; }
__device__ __forceinline__ TJob get_job(ArgsP ap, int j) {
    TJob J; unsigned char* ws = ap->ws;
    const float* norm_mix = ap->in[1]; const float* norm_ffn = ap->in[8];
    if (j < 6) { const int L = j / 3, k = j % 3;
        if (k == 0) { J.src = ap->in[2] + (size_t)L * 1024 * 3072; J.gain = norm_mix + L * 1024; J.dst = (bf16_t*)(ws + WS_WQKV_A + L * SZ_WQKV); J.ld = 3072; J.ncols = 3072; J.K = 1024; J.map = 1; }
        else if (k == 1) { J.src = ap->in[3] + (size_t)L * 1024 * 1024; J.gain = nullptr; J.dst = (bf16_t*)(ws + WS_WO_A + L * SZ_WSQ); J.ld = 1024; J.ncols = 1024; J.K = 1024; J.map = 0; }
        else { J.src = ap->in[7] + (size_t)L * 1024 * 1024; J.gain = nullptr; J.dst = (bf16_t*)(ws + WS_WO_B + L * SZ_WSQ); J.ld = 1024; J.ncols = 1024; J.K = 1024; J.map = 0; }
        J.col0 = 0; J.dst_row0 = 0; return J; }
    if (j == 6) { J.src = ap->in[6]; J.gain = norm_mix + 2 * 1024; J.dst = (bf16_t*)(ws + WS_WB2); J.ld = 1024; J.col0 = 0; J.ncols = 1024; J.K = 1024; J.dst_row0 = 0; J.map = 1; return J; }
    if (j == 7) { J.src = ap->in[5]; J.gain = ap->in[4]; J.dst = (bf16_t*)(ws + WS_WB2); J.ld = 2048; J.col0 = 0; J.ncols = 2048; J.K = 1024; J.dst_row0 = 1024; J.map = 1; return J; }
    if (j == 8) { J.src = ap->in[6] + (size_t)1024 * 1024; J.gain = norm_mix + 3 * 1024; J.dst = (bf16_t*)(ws + WS_WB3); J.ld = 1024; J.col0 = 0; J.ncols = 1024; J.K = 1024; J.dst_row0 = 0; J.map = 1; return J; }
    { const int L = (j - 9) / 3, k = (j - 9) % 3; J.col0 = 0; J.dst_row0 = 0;
        if (k == 0) { J.src = ap->in[9] + (size_t)L * 1024 * 2816; J.gain = norm_ffn + L * 1024; J.dst = (bf16_t*)(ws + WS_WGU + L * SZ_WGU); J.ld = 2816; J.ncols = 2816; J.K = 1024; J.map = 2; }
        else if (k == 1) { J.src = ap->in[10] + (size_t)L * 1024 * 2816; J.gain = norm_ffn + L * 1024; J.dst = (bf16_t*)(ws + WS_WGU + L * SZ_WGU); J.ld = 2816; J.ncols = 2816; J.K = 1024; J.map = 3; }
        else { J.src = ap->in[11] + (size_t)L * 2816 * 1024; J.gain = nullptr; J.dst = (bf16_t*)(ws + WS_WDN + L * SZ_WDN); J.ld = 1024; J.ncols = 1024; J.K = 2816; J.map = 0; }
        return J; }
}

__device__ __forceinline__ int map_col(int c, int map) {
    if (map == 1) { const int p = c >> 8, hh = (c >> 6) & 3, bj = (c >> 5) & 1, tt = c & 31; return (p << 8) + (bj << 7) + (hh << 5) + tt; }
    if (map == 2) return ((c >> 7) << 8) + (c & 127);
    if (map == 3) return ((c >> 7) << 8) + 128 + (c & 127);
    return c;
}
__device__ __forceinline__ void transpose_item(const TJob& J, LAS float* scr, int item, int lane) {
    const int nblk = J.ncols / 32, kb = item / nblk, nb = item % nblk, k0 = 64 * kb, n0 = 32 * nb;
#pragma unroll
    for (int i = 0; i < 8; ++i) { const int kk = 8 * i + (lane >> 3), ch = lane & 7; const float g = J.gain ? J.gain[k0 + kk] : 1.0f;
        const f32x4 v = __builtin_nontemporal_load((const f32x4*)(J.src + (size_t)(k0 + kk) * J.ld + J.col0 + n0 + 4 * ch));
        *(LAS f32x4*)(scr + kk * 36 + 4 * ch) = v * g; }
    asm volatile("s_waitcnt lgkmcnt(0)" ::: "memory");
    const int c = lane & 7; const int drow = J.dst_row0 + map_col(n0, J.map);
#pragma unroll
    for (int j = 0; j < 4; ++j) { const int n = (lane >> 3) + 8 * j; const LAS float* s = scr + (8 * c) * 36 + n;
        u32x4 o; o.x = cvt_pk_bf16(s[0 * 36], s[1 * 36]); o.y = cvt_pk_bf16(s[2 * 36], s[3 * 36]); o.z = cvt_pk_bf16(s[4 * 36], s[5 * 36]); o.w = cvt_pk_bf16(s[6 * 36], s[7 * 36]);
        *(u32x4*)(J.dst + (size_t)(drow + n) * J.K + k0 + 8 * c) = o; }
    asm volatile("s_waitcnt lgkmcnt(0)" ::: "memory");
}
__device__ __forceinline__ float wave_sum(float v) {
#pragma unroll
    for (int o = 1; o < 64; o <<= 1) v += __shfl_xor(v, o);
    return v;
}
__device__ __forceinline__ void prologue(ArgsP ap, LAS unsigned char* lds, int gw, int ngw, int wave, int lane) {
    LAS float* scr = (LAS float*)(lds + wave * 16384);
    int total = 0;
    for (int j = 0; j < NJOBS; ++j) total += job_items(j);
    for (int it = gw; it < total; it += ngw) {
        int r = it, j = 0;
        for (; j < NJOBS; ++j) { const int n = job_items(j); if (r < n) break; r -= n; }
        const TJob J = get_job(ap, j);
        transpose_item(J, scr, r, lane);
    }
    float* rope = (float*)(ap->ws + WS_ROPE);
    for (int e = gw * 64 + lane; e < SEQ * 32; e += ngw * 64) { const int s = e >> 5, j = e & 31;
        const float inv = __builtin_amdgcn_exp2f(-(float)j * 0.41524101186092033f);
        const float ang = (float)s * inv; double rev = (double)ang * 0.15915494309189535; rev -= __builtin_floor(rev); const float rf = (float)rev;
        rope[s * 64 + j] = __builtin_amdgcn_cosf(rf); rope[s * 64 + 32 + j] = __builtin_amdgcn_sinf(rf); }
    bf16_t* hb = (bf16_t*)(ap->ws + WS_HB); float* ssq = (float*)(ap->ws + WS_SSQ); const float* xin = ap->in[0];
    for (int row = gw; row < MTOK; row += 2 * ngw) {
        const int row2 = row + ngw; const bool has2 = row2 < MTOK; const int r2 = has2 ? row2 : row;
        const f32x4* xa = (const f32x4*)(xin + (size_t)row * DM) + lane; const f32x4* xb = (const f32x4*)(xin + (size_t)r2 * DM) + lane;
        f32x4 va[4], vb[4]; float sa = 0.f, sb = 0.f;
#pragma unroll
        for (int j = 0; j < 4; ++j) { va[j] = __builtin_nontemporal_load(xa + 64 * j); vb[j] = __builtin_nontemporal_load(xb + 64 * j); }
#pragma unroll
        for (int j = 0; j < 4; ++j) { sa += (va[j][0] * va[j][0] + va[j][1] * va[j][1]) + (va[j][2] * va[j][2] + va[j][3] * va[j][3]); sb += (vb[j][0] * vb[j][0] + vb[j][1] * vb[j][1]) + (vb[j][2] * vb[j][2] + vb[j][3] * vb[j][3]); }
        sa = wave_sum(sa); sb = wave_sum(sb);
        u32x2* oa = (u32x2*)(hb + (size_t)row * DM) + lane; u32x2* ob = (u32x2*)(hb + (size_t)r2 * DM) + lane;
#pragma unroll
        for (int j = 0; j < 4; ++j) { u32x2 w; w.x = cvt_pk_bf16(va[j][0], va[j][1]); w.y = cvt_pk_bf16(va[j][2], va[j][3]); oa[64 * j] = w;
            if (has2) { u32x2 w2; w2.x = cvt_pk_bf16(vb[j][0], vb[j][1]); w2.y = cvt_pk_bf16(vb[j][2], vb[j][3]); ob[64 * j] = w2; } }
        if (lane < 16) { ssq[(size_t)row * 16 + lane] = (lane == 0) ? sa : 0.f; if (has2) ssq[(size_t)row2 * 16 + lane] = (lane == 0) ? sb : 0.f; }
    }
}
__device__ __forceinline__ void final_norm(ArgsP ap, int gw, int ngw, int lane) {
    const float* ssq = (const float*)(ap->ws + WS_SSQ); float* outp = ap->out; const float* nf = ap->in[12]; const bf16_t* hb = (const bf16_t*)(ap->ws + WS_HB);
    f32x4 g[4];
#pragma unroll
    for (int j = 0; j < 4; ++j) g[j] = ((const f32x4*)nf)[lane + 64 * j];
    for (int row = gw; row < MTOK; row += 2 * ngw) {
        const int row2 = row + ngw; const bool has2 = row2 < MTOK; const int r2 = has2 ? row2 : row;
        const float rsa = pg8::row_rstd(ssq, (size_t)row), rsb = pg8::row_rstd(ssq, (size_t)r2);
        const u32x2* ha = (const u32x2*)(hb + (size_t)row * DM) + lane; const u32x2* hbp = (const u32x2*)(hb + (size_t)r2 * DM) + lane;
        f32x4* xa = (f32x4*)(outp + (size_t)row * DM) + lane; f32x4* xb = (f32x4*)(outp + (size_t)r2 * DM) + lane;
        u32x2 oa[4], ob[4];
#pragma unroll
        for (int j = 0; j < 4; ++j) { oa[j] = __builtin_nontemporal_load(ha + 64 * j); ob[j] = __builtin_nontemporal_load(hbp + 64 * j); }
#pragma unroll
        for (int j = 0; j < 4; ++j) { f32x4 v;
            v[0] = __uint_as_float(oa[j].x << 16); v[1] = __uint_as_float(oa[j].x & 0xffff0000u); v[2] = __uint_as_float(oa[j].y << 16); v[3] = __uint_as_float(oa[j].y & 0xffff0000u);
            __builtin_nontemporal_store(v * rsa * g[j], xa + 64 * j);
            if (has2) { v[0] = __uint_as_float(ob[j].x << 16); v[1] = __uint_as_float(ob[j].x & 0xffff0000u); v[2] = __uint_as_float(ob[j].y << 16); v[3] = __uint_as_float(ob[j].y & 0xffff0000u);
                __builtin_nontemporal_store(v * rsb * g[j], xb + 64 * j); } }
    }
}

__device__ __forceinline__ bf16x8 pack8(const float* w) {
    u32x4 p; p.x = cvt_pk_bf16(w[0], w[1]); p.y = cvt_pk_bf16(w[2], w[3]); p.z = cvt_pk_bf16(w[4], w[5]); p.w = cvt_pk_bf16(w[6], w[7]);
    return __builtin_bit_cast(bf16x8, p);
}
__device__ __forceinline__ void store_o(bf16_t* orow, const f32x16& o0, const f32x16& o1, float sc, int hi) {
#pragma unroll
    for (int g = 0; g < 4; ++g) {
        u32x2 w; w.x = cvt_pk_bf16(o0[4 * g] * sc, o0[4 * g + 1] * sc); w.y = cvt_pk_bf16(o0[4 * g + 2] * sc, o0[4 * g + 3] * sc); *(u32x2*)(orow + 8 * g + 4 * hi) = w;
        w.x = cvt_pk_bf16(o1[4 * g] * sc, o1[4 * g + 1] * sc); w.y = cvt_pk_bf16(o1[4 * g + 2] * sc, o1[4 * g + 3] * sc); *(u32x2*)(orow + 32 + 8 * g + 4 * hi) = w;
    }
}
constexpr int SCR_PITCH = 144, SCR_BYTES = 32 * SCR_PITCH, SCR_OFF = 40960;
__device__ __forceinline__ void rows_to_lds(LAS unsigned char* scr, const bf16_t* base, int t0, int ts, int lane) {
#pragma unroll
    for (int k = 0; k < 4; ++k) { const int row = 8 * k + (lane >> 3), ch = lane & 7; const u32x4 v = __builtin_nontemporal_load((const u32x4*)(base + (size_t)(t0 + ts * row) * DM + ch * 8)); *(LAS u32x4*)(scr + row * SCR_PITCH + ch * 16) = v; }
}
__device__ __forceinline__ void lds_to_rows(LAS unsigned char* scr, bf16_t* base, int t0, int ts, int lane) {
#pragma unroll
    for (int k = 0; k < 4; ++k) { const int row = 8 * k + (lane >> 3), ch = lane & 7; const u32x4 v = *(LAS u32x4*)(scr + row * SCR_PITCH + ch * 16); __builtin_nontemporal_store(v, (u32x4*)(base + (size_t)(t0 + ts * row) * DM + ch * 8)); }
}
__device__ __forceinline__ void o_to_lds(LAS unsigned char* scr, const f32x16& o0, const f32x16& o1, float sc, int r32, int hi) {
#pragma unroll
    for (int g = 0; g < 4; ++g) {
        u32x2 w; w.x = cvt_pk_bf16(o0[4 * g] * sc, o0[4 * g + 1] * sc); w.y = cvt_pk_bf16(o0[4 * g + 2] * sc, o0[4 * g + 3] * sc); *(LAS u32x2*)(scr + r32 * SCR_PITCH + (8 * g + 4 * hi) * 2) = w;
        w.x = cvt_pk_bf16(o1[4 * g] * sc, o1[4 * g + 1] * sc); w.y = cvt_pk_bf16(o1[4 * g + 2] * sc, o1[4 * g + 3] * sc); *(LAS u32x2*)(scr + r32 * SCR_PITCH + (32 + 8 * g + 4 * hi) * 2) = w;
    }
}
__device__ __forceinline__ void sb_unit(const bf16_t* Q, const bf16_t* Kb, const bf16_t* Vt, bf16_t* O, int bh, int qb, int lane, int cap = 1 << 30) {
    const int b = bh >> 4, h = bh & 15, r32 = lane & 31, hi = lane >> 5;
    const size_t rowbase = (size_t)b * SEQ;
    const bf16_t* qp = Q + (rowbase + qb * 32 + r32) * DM + h * HD + 8 * hi;
    bf16x8 qf[4];
#pragma unroll
    for (int s = 0; s < 4; ++s) qf[s] = *(const bf16x8*)(qp + 16 * s);
    const bf16_t* kp = Kb + (size_t)bh * (128 * 2048) + lane * 8;
    const bf16_t* vp = Vt + (size_t)bh * (128 * 2048) + lane * 8;
    f32x16 o0 = {}, o1 = {}; float P = 1.0f;
    bf16x8 kA[4], vA[4], kB[4], vB[4], kC[4], vC[4];
#define SB_LOAD(KF, VF, JT) do { { const int jt_ = (JT) < 0 ? 0 : (JT); const bf16_t* kt_ = kp + jt_ * 2048; const bf16_t* vt_ = vp + jt_ * 2048; \
        _Pragma("unroll") for (int s = 0; s < 4; ++s) { KF[s] = *(const bf16x8*)(kt_ + 512 * s); VF[s] = *(const bf16x8*)(vt_ + 512 * s); } } } while (0)
#define SB_STEP(KF, VF, JT) do { \
        f32x16 S = {}; \
        _Pragma("unroll") for (int s = 0; s < 4; ++s) S = __builtin_amdgcn_mfma_f32_32x32x16_bf16(KF[s], qf[s], S, 0, 0, 0); \
        float r[16]; const bool diag = ((JT) == qb); \
        _Pragma("unroll") for (int i = 0; i < 16; ++i) { float e = __builtin_amdgcn_exp2f(S[i]); if (diag && (16 * hi + i >= r32)) e = 0.f; r[i] = __builtin_amdgcn_rcpf(1.0f + e); } \
        const float t8a = ((r[8] * r[9]) * (r[10] * r[11])) * ((r[12] * r[13]) * (r[14] * r[15])), t8b = ((r[0] * r[1]) * (r[2] * r[3])) * ((r[4] * r[5]) * (r[6] * r[7])), tot = t8a * t8b; \
        auto rr = __builtin_amdgcn_permlane32_swap(__float_as_uint(tot), __float_as_uint(tot), false, false); \
        const float tot_lo = __uint_as_float(rr[0]), tot_hi = __uint_as_float(rr[1]); \
        float A = hi ? P : P * tot_hi; float B2 = A * t8a; P = P * tot_lo * tot_hi; float w[16];        \
        _Pragma("unroll") for (int i = 7; i >= 0; --i) { const float An = A * r[8 + i]; w[8 + i] = A - An; A = An; const float Bn = B2 * r[i]; w[i] = B2 - Bn; B2 = Bn; } \
        const bf16x8 p0 = pack8(w), p1 = pack8(w + 8); \
        o0 = __builtin_amdgcn_mfma_f32_32x32x16_bf16(VF[0], p0, o0, 0, 0, 0); o0 = __builtin_amdgcn_mfma_f32_32x32x16_bf16(VF[1], p1, o0, 0, 0, 0); \
        o1 = __builtin_amdgcn_mfma_f32_32x32x16_bf16(VF[2], p0, o1, 0, 0, 0); o1 = __builtin_amdgcn_mfma_f32_32x32x16_bf16(VF[3], p1, o1, 0, 0, 0); } while (0)
    SB_LOAD(kA, vA, qb); SB_LOAD(kB, vB, qb - 1);
    for (int jt = qb; jt >= 0 && jt > qb - cap; jt -= 3) {
        SB_LOAD(kC, vC, jt - 2); SB_STEP(kA, vA, jt);     if (jt - 1 < 0 || __ballot(P != 0.0f) == 0ull) break;
        SB_LOAD(kA, vA, jt - 3); SB_STEP(kB, vB, jt - 1); if (jt - 2 < 0 || __ballot(P != 0.0f) == 0ull) break;
        SB_LOAD(kB, vB, jt - 4); SB_STEP(kC, vC, jt - 2); if (__ballot(P != 0.0f) == 0ull) break;
    }
#undef SB_LOAD
#undef SB_STEP
    store_o(O + (rowbase + qb * 32 + r32) * DM + h * HD, o0, o1, 1.0f, hi);
}

struct DTile { int cb, cs, ibase, is, wr, valid; };
template <int MODE> __device__ __forceinline__ DTile dil_decode(int tt, int c, int ib) {
    DTile d;
    if (MODE == 0) { const int w = (ib >> 2) - 1 + (tt >> 2); d.cb = 4 * (tt & 3); d.cs = 1; d.ibase = 8 * w; d.is = 0; d.wr = 128; d.valid = w >= 0; }
    else if (tt < 5) { const int w = ib - 4 + tt; d.cb = c; d.cs = 0; d.ibase = 32 * w; d.is = 8; d.wr = 2048; d.valid = w >= 0; }
    else { const int w = 4 * ib - 4 + (tt - 5); d.cb = c & 3; d.cs = 4; d.ibase = 8 * w; d.is = 0; d.wr = 512; d.valid = w >= 0; }
    return d;
}
__device__ __forceinline__ void dil_load(const DTile& d, const bf16_t* kq, const bf16_t* vq, int rho_m, int j_m, int hi, bf16x8* kf, bf16x8* vf) {
    const int ib0 = d.valid ? d.ibase : 0;
    const bf16_t* kt = kq + (size_t)((d.cb + d.cs * rho_m) * 32 + ((ib0 + d.is * rho_m) >> 3)) * 512;
#pragma unroll
    for (int s = 0; s < 4; ++s) kf[s] = *(const bf16x8*)(kt + s * 128);
#pragma unroll
    for (int u = 0; u < 2; ++u) { const int rho = 2 * hi + u; const bf16_t* vt = vq + (size_t)((d.cb + d.cs * rho) * 32 + ((ib0 + d.is * rho) >> 3)) * 512;
        vf[u] = *(const bf16x8*)(vt); vf[2 + u] = *(const bf16x8*)(vt + 256); }
}
__device__ __forceinline__ void dil_load_u(const bf16_t* kbh, const bf16_t* vbh, unsigned sbase, unsigned kro, unsigned vro0, unsigned vro1, bf16x8* kf, bf16x8* vf) {
    const bf16_t* kt = kbh + sbase; const bf16_t* vt = vbh + sbase;
#pragma unroll
    for (int s = 0; s < 4; ++s) kf[s] = *(const bf16x8*)(kt + (kro + s * 128));
    vf[0] = *(const bf16x8*)(vt + vro0); vf[1] = *(const bf16x8*)(vt + vro1); vf[2] = *(const bf16x8*)(vt + (vro0 + 256)); vf[3] = *(const bf16x8*)(vt + (vro1 + 256));
}
template <int MODE> __device__ __forceinline__ void dil_unit(const bf16_t* Q, const bf16_t* Kb, const bf16_t* Vt, bf16_t* O, bf16_t* X1, float* LSE, int bh, int c, int ib, int lane, LAS unsigned char* scr, int ntcap = 64) {
    constexpr int NT = MODE == 0 ? 8 : 13;
    const int b = bh >> 4, h = bh & 15, r32 = lane & 31, hi = lane >> 5;
    const size_t rowbase = (size_t)b * SEQ;
    const int tq = MODE == 0 ? 32 * ib + r32 : c + 16 * (32 * ib + r32);
    const int t0 = MODE == 0 ? 32 * ib : c + 512 * ib, ts = MODE == 0 ? 1 : 16;
    rows_to_lds(scr, Q + rowbase * DM + h * HD, t0, ts, lane);
    bf16x8 qf[4];
#pragma unroll
    for (int s = 0; s < 4; ++s) qf[s] = *(LAS bf16x8*)(scr + r32 * SCR_PITCH + (2 * s + hi) * 16);
    const int u_m = (r32 >> 4) & 1, hi_m = (r32 >> 2) & 1, j_m = (r32 & 3) + 4 * ((r32 >> 3) & 1), rho_m = 2 * hi_m + u_m;
    const bf16_t* kq = Kb + (size_t)bh * (16 * 32 * 512) + (8 * hi + j_m) * 8;
    const bf16_t* vq = Vt + (size_t)bh * (16 * 32 * 512) + r32 * 8;
    f32x16 o0 = {}, o1 = {}; float mrun = -1e30f, l = 0.f;
    bf16x8 kA[4], vA[4], kB[4], vB[4], kC[4], vC[4];
    const bf16_t* kbh = Kb + (size_t)bh * (16 * 32 * 512); const bf16_t* vbh = Vt + (size_t)bh * (16 * 32 * 512);
    const unsigned kl_ = (unsigned)((8 * hi + j_m) * 8), vl_ = (unsigned)(r32 * 8);
    const unsigned kro16 = kl_ + rho_m * 512u, kro4 = kl_ + rho_m * 65536u, vro16 = vl_ + (2 * hi) * 512u, vro4 = vl_ + (2 * hi) * 65536u;
#define DL_LOAD(KF, VF, TT) do { const int tt_ = (TT) < NT ? (TT) : NT - 1; \
        if (MODE == 1) { const bool r16_ = tt_ < 5; const int w_ = r16_ ? ib - 4 + tt_ : 4 * ib - 4 + (tt_ - 5); const int wc_ = w_ < 0 ? 0 : w_; \
            const unsigned sb_ = r16_ ? (unsigned)((c * 32 + 4 * wc_) * 512) : (unsigned)(((c & 3) * 32 + wc_) * 512); \
            dil_load_u(kbh, vbh, sb_, r16_ ? kro16 : kro4, r16_ ? vro16 : vro4, r16_ ? vro16 + 512u : vro4 + 65536u, KF, VF); } \
        else { const DTile d_ = dil_decode<MODE>(tt_, c, ib); dil_load(d_, kq, vq, rho_m, j_m, hi, KF, VF); } } while (0)
#define DL_STEP(KF, VF, TT) do { const DTile dc = dil_decode<MODE>((TT), c, ib); if ((TT) < NT && (TT) < ntcap && dc.valid) { \
        f32x16 S = {}; \
        _Pragma("unroll") for (int s = 0; s < 4; ++s) S = __builtin_amdgcn_mfma_f32_32x32x16_bf16(KF[s], qf[s], S, 0, 0, 0); \
        const int stride = 16 * dc.is + dc.cs; const int dA = tq - 16 * dc.ibase - dc.cb - 2 * hi * stride, dB = dA - stride; \
        float z[16]; \
        if (MODE == 1 && (TT) >= 1 && (TT) <= 3) { _Pragma("unroll") for (int i = 0; i < 16; ++i) z[i] = S[i]; }        \
        else { _Pragma("unroll") for (int i = 0; i < 16; ++i) { const bool ok = (unsigned)(((i >> 3) ? dB : dA) - 16 * (i & 7)) <= (unsigned)dc.wr; z[i] = ok ? S[i] : -INFINITY; } } \
        float mx = __builtin_fmaxf(__builtin_fmaxf(__builtin_fmaxf(__builtin_fmaxf(z[0], z[1]), __builtin_fmaxf(z[2], z[3])), __builtin_fmaxf(__builtin_fmaxf(z[4], z[5]), __builtin_fmaxf(z[6], z[7]))), \
                                   __builtin_fmaxf(__builtin_fmaxf(__builtin_fmaxf(z[8], z[9]), __builtin_fmaxf(z[10], z[11])), __builtin_fmaxf(__builtin_fmaxf(z[12], z[13]), __builtin_fmaxf(z[14], z[15])))); \
        auto rr = __builtin_amdgcn_permlane32_swap(__float_as_uint(mx), __float_as_uint(mx), false, false); \
        mx = fmaxf(__uint_as_float(rr[0]), __uint_as_float(rr[1])); \
        if (__ballot(mx > mrun) != 0ull) { const float mnew = fmaxf(mrun, mx); const float alpha = __builtin_amdgcn_exp2f(mrun - mnew); mrun = mnew; l *= alpha; \
            _Pragma("unroll") for (int i = 0; i < 16; ++i) { o0[i] *= alpha; o1[i] *= alpha; } } \
        float p[16]; \
        _Pragma("unroll") for (int i = 0; i < 16; ++i) p[i] = __builtin_amdgcn_exp2f(z[i] - mrun); \
        l += (((p[0] + p[1]) + (p[2] + p[3])) + ((p[4] + p[5]) + (p[6] + p[7]))) + (((p[8] + p[9]) + (p[10] + p[11])) + ((p[12] + p[13]) + (p[14] + p[15]))); \
        const bf16x8 p0 = pack8(p), p1 = pack8(p + 8); \
        o0 = __builtin_amdgcn_mfma_f32_32x32x16_bf16(VF[0], p0, o0, 0, 0, 0); o0 = __builtin_amdgcn_mfma_f32_32x32x16_bf16(VF[1], p1, o0, 0, 0, 0); \
        o1 = __builtin_amdgcn_mfma_f32_32x32x16_bf16(VF[2], p0, o1, 0, 0, 0); o1 = __builtin_amdgcn_mfma_f32_32x32x16_bf16(VF[3], p1, o1, 0, 0, 0); } } while (0)
    DL_LOAD(kA, vA, 0); DL_LOAD(kB, vB, 1);
    for (int tt = 0; tt < NT; tt += 3) {
        DL_LOAD(kC, vC, tt + 2); DL_STEP(kA, vA, tt);
        DL_LOAD(kA, vA, tt + 3); DL_STEP(kB, vB, tt + 1);
        DL_LOAD(kB, vB, tt + 4); DL_STEP(kC, vC, tt + 2);
    }
#undef DL_LOAD
#undef DL_STEP
    auto rr = __builtin_amdgcn_permlane32_swap(__float_as_uint(l), __float_as_uint(l), false, false);
    const float lt = __uint_as_float(rr[0]) + __uint_as_float(rr[1]);
    const size_t orow = (rowbase + tq) * DM + h * HD;
    if (MODE == 0) {
        o_to_lds(scr, o0, o1, 1.0f / lt, r32, hi); lds_to_rows(scr, X1 + rowbase * DM + h * HD, t0, ts, lane);
        if (hi == 0) LSE[(rowbase + tq) * 16 + h] = mrun + __builtin_amdgcn_logf(lt);
    } else {
        rows_to_lds(scr, X1 + rowbase * DM + h * HD, t0, ts, lane);
        const float lse1 = LSE[(rowbase + tq) * 16 + h];
        const float M = fmaxf(mrun, lse1), w2 = __builtin_amdgcn_exp2f(mrun - M), w1 = __builtin_amdgcn_exp2f(lse1 - M), inv = 1.0f / (lt * w2 + w1), a2 = w2 * inv, a1 = w1 * inv;
#pragma unroll
        for (int g = 0; g < 4; ++g) {
            const u32x2 x0 = *(LAS u32x2*)(scr + r32 * SCR_PITCH + (8 * g + 4 * hi) * 2), x1 = *(LAS u32x2*)(scr + r32 * SCR_PITCH + (32 + 8 * g + 4 * hi) * 2);
            o0[4 * g] = o0[4 * g] * a2 + __uint_as_float(x0.x << 16) * a1; o0[4 * g + 1] = o0[4 * g + 1] * a2 + __uint_as_float(x0.x & 0xffff0000u) * a1;
            o0[4 * g + 2] = o0[4 * g + 2] * a2 + __uint_as_float(x0.y << 16) * a1; o0[4 * g + 3] = o0[4 * g + 3] * a2 + __uint_as_float(x0.y & 0xffff0000u) * a1;
            o1[4 * g] = o1[4 * g] * a2 + __uint_as_float(x1.x << 16) * a1; o1[4 * g + 1] = o1[4 * g + 1] * a2 + __uint_as_float(x1.x & 0xffff0000u) * a1;
            o1[4 * g + 2] = o1[4 * g + 2] * a2 + __uint_as_float(x1.y << 16) * a1; o1[4 * g + 3] = o1[4 * g + 3] * a2 + __uint_as_float(x1.y & 0xffff0000u) * a1;
        }
        o_to_lds(scr, o0, o1, 1.0f, r32, hi); lds_to_rows(scr, O + rowbase * DM + h * HD, t0, ts, lane);
    }
}


#define ATT_WAITBAR() asm volatile("s_waitcnt lgkmcnt(0)\n\ts_barrier" ::: "memory")
typedef LAS bf16x8* lds_v8;
__device__ __forceinline__ void sb_group(const bf16_t* Q, const bf16_t* Kb, const bf16_t* Vt, bf16_t* O, int bh, int g, int tid, LAS unsigned char* lds) {
    const int lane = tid & 63, wave = __builtin_amdgcn_readfirstlane(tid >> 6), r32 = lane & 31, hi = lane >> 5;
    const int b = bh >> 4, h = bh & 15, qb = 8 * g + wave, top = 8 * g + 7;
    const size_t rowbase = (size_t)b * SEQ;
    LAS unsigned char* scr = lds + SCR_OFF + wave * SCR_BYTES;
    rows_to_lds(scr, Q + rowbase * DM + h * HD, qb * 32, 1, lane);
    bf16x8 qf[4];
#pragma unroll
    for (int s = 0; s < 4; ++s) qf[s] = *(LAS bf16x8*)(scr + r32 * SCR_PITCH + (2 * s + hi) * 16);
    const bf16_t* src = ((tid < 256) ? Kb : Vt) + (size_t)bh * (128 * 2048) + (tid & 255) * 8;
    LAS unsigned char* dst = lds + tid * 16;
    LAS unsigned char* rdp = lds + lane * 16;
    volatile LAS unsigned* flags = (volatile LAS unsigned*)(lds + 32768);
#define SG_GLOAD(JT) (*(const bf16x8*)(src + (size_t)((JT) < 0 ? 0 : (JT)) * 2048))
    bf16x8 r0 = SG_GLOAD(top), r1 = SG_GLOAD(top - 1), rh = SG_GLOAD(top - 2);
    ATT_WAITBAR();
    *(lds_v8)(dst) = r0; *(lds_v8)(dst + 8192) = r1;
    f32x16 o0 = {}, o1 = {}; float P = 1.0f;
    for (int t = 0; ; ++t) {
        const int jt = top - t, slot = (t & 3) * 8192;
        const bf16x8 rn = SG_GLOAD(jt - 3);
        *(lds_v8)(dst + ((t + 2) & 3) * 8192) = rh;
        const bool mine = (jt <= qb) && (jt >= 0) && (__ballot(P != 0.0f) != 0ull);
        if (lane == 0) flags[(t & 1) * 8 + wave] = (jt >= 0 && (jt > qb || mine)) ? 1u : 0u;
        ATT_WAITBAR();
        { const u32x4 fa = *(LAS u32x4*)(lds + 32768 + (t & 1) * 32), fb = *(LAS u32x4*)(lds + 32768 + (t & 1) * 32 + 16);
          if (((fa.x | fa.y) | (fa.z | fa.w) | (fb.x | fb.y) | (fb.z | fb.w)) == 0u) break; }
        if (mine) {
            bf16x8 KF[4], VF[4];
#pragma unroll
            for (int s = 0; s < 4; ++s) { KF[s] = *(lds_v8)(rdp + slot + s * 1024); VF[s] = *(lds_v8)(rdp + slot + 4096 + s * 1024); }
            f32x16 S = {};
#pragma unroll
            for (int s = 0; s < 4; ++s) S = __builtin_amdgcn_mfma_f32_32x32x16_bf16(KF[s], qf[s], S, 0, 0, 0);
            float r[16]; const bool diag = (jt == qb);
#pragma unroll
            for (int i = 0; i < 16; ++i) { float e = __builtin_amdgcn_exp2f(S[i]); if (diag && (16 * hi + i >= r32)) e = 0.f; r[i] = __builtin_amdgcn_rcpf(1.0f + e); }
            const float t8a = ((r[8] * r[9]) * (r[10] * r[11])) * ((r[12] * r[13]) * (r[14] * r[15])), t8b = ((r[0] * r[1]) * (r[2] * r[3])) * ((r[4] * r[5]) * (r[6] * r[7])), tot = t8a * t8b;
            auto rr = __builtin_amdgcn_permlane32_swap(__float_as_uint(tot), __float_as_uint(tot), false, false);
            const float tot_lo = __uint_as_float(rr[0]), tot_hi = __uint_as_float(rr[1]);
            float A = hi ? P : P * tot_hi; float B2 = A * t8a; P = P * tot_lo * tot_hi; float w[16];
#pragma unroll
            for (int i = 7; i >= 0; --i) { const float An = A * r[8 + i]; w[8 + i] = A - An; A = An; const float Bn = B2 * r[i]; w[i] = B2 - Bn; B2 = Bn; }
            const bf16x8 p0 = pack8(w), p1 = pack8(w + 8);
            o0 = __builtin_amdgcn_mfma_f32_32x32x16_bf16(VF[0], p0, o0, 0, 0, 0); o0 = __builtin_amdgcn_mfma_f32_32x32x16_bf16(VF[1], p1, o0, 0, 0, 0);
            o1 = __builtin_amdgcn_mfma_f32_32x32x16_bf16(VF[2], p0, o1, 0, 0, 0); o1 = __builtin_amdgcn_mfma_f32_32x32x16_bf16(VF[3], p1, o1, 0, 0, 0);
        }
        rh = rn;
    }
#undef SG_GLOAD
    o_to_lds(scr, o0, o1, 1.0f, r32, hi);
    lds_to_rows(scr, O + rowbase * DM + h * HD, qb * 32, 1, lane);
}
constexpr int SBW_TILES = 14, SBW_SCR = SBW_TILES * 8192;
__device__ __forceinline__ void sb_step(const bf16x8* KF, const bf16x8* VF, const bf16x8* qf, f32x16& o0, f32x16& o1, float& P, bool diag, int r32, int hi) {
    f32x16 S = {};
#pragma unroll
    for (int s = 0; s < 4; ++s) S = __builtin_amdgcn_mfma_f32_32x32x16_bf16(KF[s], qf[s], S, 0, 0, 0);
    float r[16];
#pragma unroll
    for (int i = 0; i < 16; ++i) { float e = __builtin_amdgcn_exp2f(S[i]); if (diag && (16 * hi + i >= r32)) e = 0.f; r[i] = __builtin_amdgcn_rcpf(1.0f + e); }
    const float t8a = ((r[8] * r[9]) * (r[10] * r[11])) * ((r[12] * r[13]) * (r[14] * r[15])), t8b = ((r[0] * r[1]) * (r[2] * r[3])) * ((r[4] * r[5]) * (r[6] * r[7])), tot = t8a * t8b;
    auto rr = __builtin_amdgcn_permlane32_swap(__float_as_uint(tot), __float_as_uint(tot), false, false);
    const float tot_lo = __uint_as_float(rr[0]), tot_hi = __uint_as_float(rr[1]);
    float A = hi ? P : P * tot_hi; float B2 = A * t8a; P = P * tot_lo * tot_hi; float w[16];
#pragma unroll
    for (int i = 7; i >= 0; --i) { const float An = A * r[8 + i]; w[8 + i] = A - An; A = An; const float Bn = B2 * r[i]; w[i] = B2 - Bn; B2 = Bn; }
    const bf16x8 p0 = pack8(w), p1 = pack8(w + 8);
    o0 = __builtin_amdgcn_mfma_f32_32x32x16_bf16(VF[0], p0, o0, 0, 0, 0); o0 = __builtin_amdgcn_mfma_f32_32x32x16_bf16(VF[1], p1, o0, 0, 0, 0);
    o1 = __builtin_amdgcn_mfma_f32_32x32x16_bf16(VF[2], p0, o1, 0, 0, 0); o1 = __builtin_amdgcn_mfma_f32_32x32x16_bf16(VF[3], p1, o1, 0, 0, 0);
}
__device__ __forceinline__ void sb_groups(const bf16_t* Q, const bf16_t* Kb, const bf16_t* Vt, bf16_t* O, int bid, int G, int tid, LAS unsigned char* lds) {
    const int lane = tid & 63, wave = __builtin_amdgcn_readfirstlane(tid >> 6), r32 = lane & 31, hi = lane >> 5;
    LAS unsigned char* scr = lds + SBW_SCR + wave * SCR_BYTES;
    LAS unsigned char* wdst = lds + tid * 16;
    LAS unsigned char* rdp = lds + lane * 16;
    bf16x8 W[SBW_TILES]; u32x4 QR[4];
#define SBW_ITEM(U, BH, GR) const int BH = (U) & 255, GR = (((U) >> 8) & 1) ? 15 - ((U) >> 9) : ((U) >> 9)
#define SBW_PREFETCH(U) do { SBW_ITEM(U, bh_, g_); const int top_ = 8 * g_ + 7; \
        const bf16_t* src_ = ((tid < 256) ? Kb : Vt) + (size_t)bh_ * (128 * 2048) + (tid & 255) * 8; \
        _Pragma("unroll") for (int k = 0; k < SBW_TILES; ++k) { const int jt_ = top_ - k; W[k] = *(const bf16x8*)(src_ + (size_t)(jt_ < 0 ? 0 : jt_) * 2048); } \
        const bf16_t* qb_ = Q + ((size_t)(bh_ >> 4) * SEQ) * DM + (bh_ & 15) * HD; \
        _Pragma("unroll") for (int k = 0; k < 4; ++k) QR[k] = __builtin_nontemporal_load((const u32x4*)(qb_ + (size_t)((8 * g_ + wave) * 32 + 8 * k + (lane >> 3)) * DM + (lane & 7) * 8)); } while (0)
    if (bid < 4096) SBW_PREFETCH(bid);
    for (int unit = bid; unit < 4096; unit += G) {
        SBW_ITEM(unit, bh, g);
        const int b = bh >> 4, h = bh & 15, qb = 8 * g + wave, top = 8 * g + 7, wlo = top - (SBW_TILES - 1);
        const size_t rowbase = (size_t)b * SEQ;
        ATT_WAITBAR();
#pragma unroll
        for (int k = 0; k < SBW_TILES; ++k) *(lds_v8)(wdst + k * 8192) = W[k];
#pragma unroll
        for (int k = 0; k < 4; ++k) *(LAS u32x4*)(scr + (8 * k + (lane >> 3)) * SCR_PITCH + (lane & 7) * 16) = QR[k];
        ATT_WAITBAR();
        if (unit + G < 4096) SBW_PREFETCH(unit + G);
        bf16x8 qf[4];
#pragma unroll
        for (int s = 0; s < 4; ++s) qf[s] = *(LAS bf16x8*)(scr + r32 * SCR_PITCH + (2 * s + hi) * 16);
        f32x16 o0 = {}, o1 = {}; float P = 1.0f; int jt = qb;
        for (; jt >= 0 && jt >= wlo; --jt) {
            const int slot = (top - jt) * 8192; bf16x8 KF[4], VF[4];
#pragma unroll
            for (int s = 0; s < 4; ++s) { KF[s] = *(lds_v8)(rdp + slot + s * 1024); VF[s] = *(lds_v8)(rdp + slot + 4096 + s * 1024); }
            sb_step(KF, VF, qf, o0, o1, P, jt == qb, r32, hi);
            if (__ballot(P != 0.0f) == 0ull) { jt = -1; break; }
        }
        for (; jt >= 0; --jt) {
            const bf16_t* kt = Kb + (size_t)bh * (128 * 2048) + (size_t)jt * 2048 + lane * 8; const bf16_t* vt = Vt + (size_t)bh * (128 * 2048) + (size_t)jt * 2048 + lane * 8; bf16x8 KF[4], VF[4];
#pragma unroll
            for (int s = 0; s < 4; ++s) { KF[s] = *(const bf16x8*)(kt + 512 * s); VF[s] = *(const bf16x8*)(vt + 512 * s); }
            sb_step(KF, VF, qf, o0, o1, P, false, r32, hi);
            if (__ballot(P != 0.0f) == 0ull) break;
        }
        o_to_lds(scr, o0, o1, 1.0f, r32, hi);
        lds_to_rows(scr, O + rowbase * DM + h * HD, qb * 32, 1, lane);
    }
#undef SBW_ITEM
#undef SBW_PREFETCH
}
__device__ __forceinline__ void dil_group0(const bf16_t* Q, const bf16_t* Kb, const bf16_t* Vt, bf16_t* X1, float* LSE, int bh, int g, int tid, LAS unsigned char* lds) {
    const int lane = tid & 63, wave = __builtin_amdgcn_readfirstlane(tid >> 6), r32 = lane & 31, hi = lane >> 5;
    const int b = bh >> 4, h = bh & 15, blk = 8 * g + wave, tq = 32 * blk + r32, vlo = wave >> 2;
    const size_t rowbase = (size_t)b * SEQ;
    LAS unsigned char* scr = lds + SCR_OFF + wave * SCR_BYTES;
    rows_to_lds(scr, Q + rowbase * DM + h * HD, 32 * blk, 1, lane);
    bf16x8 qf[4];
#pragma unroll
    for (int s = 0; s < 4; ++s) qf[s] = *(LAS bf16x8*)(scr + r32 * SCR_PITCH + (2 * s + hi) * 16);
    const int u_m = (r32 >> 4) & 1, hi_m = (r32 >> 2) & 1, j_m = (r32 & 3) + 4 * ((r32 >> 3) & 1), rho_m = 2 * hi_m + u_m;
    const int part = tid >> 6, rho_s = part & 3;
    const bf16_t* src = ((part < 4) ? Kb : Vt) + (size_t)bh * (16 * 32 * 512) + (size_t)rho_s * (32 * 512) + (tid & 63) * 8;
    LAS unsigned char* dst = lds + part * 1024 + (tid & 63) * 16;
    LAS unsigned char* krd = lds + rho_m * 1024 + (hi * 8 + j_m) * 16;
    LAS unsigned char* vrd = lds + 4096 + (2 * hi) * 1024 + r32 * 16;
#define DG_GLOAD(T) (*(const bf16x8*)(src + (size_t)((((T) < 12 ? (T) : 11) & 3) * 4 * 32 + (2 * g - 1 + (((T) < 12 ? (T) : 11) >> 2) < 0 ? 0 : 2 * g - 1 + (((T) < 12 ? (T) : 11) >> 2))) * 512))
    bf16x8 r0 = DG_GLOAD(0), r1 = DG_GLOAD(1), rh = DG_GLOAD(2);
    ATT_WAITBAR();
    *(lds_v8)(dst) = r0; *(lds_v8)(dst + 8192) = r1;
    f32x16 o0 = {}, o1 = {}; float mrun = -1e30f, l = 0.f;
    for (int t = 0; t < 12; ++t) {
        const int v = t >> 2, a = t & 3, w = 2 * g - 1 + v, slot = (t & 3) * 8192;
        const bf16x8 rn = DG_GLOAD(t + 3);
        *(lds_v8)(dst + ((t + 2) & 3) * 8192) = rh;
        ATT_WAITBAR();
        if (w >= 0 && (v == vlo || v == vlo + 1)) {
            bf16x8 KF[4], VF[4];
#pragma unroll
            for (int s = 0; s < 4; ++s) KF[s] = *(lds_v8)(krd + slot + s * 256);
            VF[0] = *(lds_v8)(vrd + slot); VF[1] = *(lds_v8)(vrd + slot + 1024); VF[2] = *(lds_v8)(vrd + slot + 512); VF[3] = *(lds_v8)(vrd + slot + 1024 + 512);
            f32x16 S = {};
#pragma unroll
            for (int s = 0; s < 4; ++s) S = __builtin_amdgcn_mfma_f32_32x32x16_bf16(KF[s], qf[s], S, 0, 0, 0);
            const int dA = tq - 128 * w - 4 * a - 2 * hi, dB = dA - 1;
            float z[16];
#pragma unroll
            for (int i = 0; i < 16; ++i) { const bool ok = (unsigned)(((i >> 3) ? dB : dA) - 16 * (i & 7)) <= 128u; z[i] = ok ? S[i] : -INFINITY; }
            float mx = __builtin_fmaxf(__builtin_fmaxf(__builtin_fmaxf(__builtin_fmaxf(z[0], z[1]), __builtin_fmaxf(z[2], z[3])), __builtin_fmaxf(__builtin_fmaxf(z[4], z[5]), __builtin_fmaxf(z[6], z[7]))),
                                       __builtin_fmaxf(__builtin_fmaxf(__builtin_fmaxf(z[8], z[9]), __builtin_fmaxf(z[10], z[11])), __builtin_fmaxf(__builtin_fmaxf(z[12], z[13]), __builtin_fmaxf(z[14], z[15]))));
            auto rr = __builtin_amdgcn_permlane32_swap(__float_as_uint(mx), __float_as_uint(mx), false, false);
            mx = fmaxf(__uint_as_float(rr[0]), __uint_as_float(rr[1]));
            if (__ballot(mx > mrun) != 0ull) { const float mnew = fmaxf(mrun, mx); const float alpha = __builtin_amdgcn_exp2f(mrun - mnew); mrun = mnew; l *= alpha;
#pragma unroll
                for (int i = 0; i < 16; ++i) { o0[i] *= alpha; o1[i] *= alpha; } }
            float p[16];
#pragma unroll
            for (int i = 0; i < 16; ++i) p[i] = __builtin_amdgcn_exp2f(z[i] - mrun);
            l += (((p[0] + p[1]) + (p[2] + p[3])) + ((p[4] + p[5]) + (p[6] + p[7]))) + (((p[8] + p[9]) + (p[10] + p[11])) + ((p[12] + p[13]) + (p[14] + p[15])));
            const bf16x8 p0 = pack8(p), p1 = pack8(p + 8);
            o0 = __builtin_amdgcn_mfma_f32_32x32x16_bf16(VF[0], p0, o0, 0, 0, 0); o0 = __builtin_amdgcn_mfma_f32_32x32x16_bf16(VF[1], p1, o0, 0, 0, 0);
            o1 = __builtin_amdgcn_mfma_f32_32x32x16_bf16(VF[2], p0, o1, 0, 0, 0); o1 = __builtin_amdgcn_mfma_f32_32x32x16_bf16(VF[3], p1, o1, 0, 0, 0);
        }
        rh = rn;
    }
#undef DG_GLOAD
    auto rr = __builtin_amdgcn_permlane32_swap(__float_as_uint(l), __float_as_uint(l), false, false);
    const float lt = __uint_as_float(rr[0]) + __uint_as_float(rr[1]);
    o_to_lds(scr, o0, o1, 1.0f / lt, r32, hi);
    lds_to_rows(scr, X1 + rowbase * DM + h * HD, 32 * blk, 1, lane);
    if (hi == 0) LSE[(rowbase + tq) * 16 + h] = mrun + __builtin_amdgcn_logf(lt);
}

__device__ __forceinline__ void dil_groups0(const bf16_t* Q, const bf16_t* Kb, const bf16_t* Vt, bf16_t* X1, float* LSE, bool xo, int xcd, int myr, int bid, int G, int tid, LAS unsigned char* lds) {
    const int lane = tid & 63, wave = __builtin_amdgcn_readfirstlane(tid >> 6), r32 = lane & 31, hi = lane >> 5, vlo = wave >> 2;
    LAS unsigned char* scr = lds + SBW_SCR + wave * SCR_BYTES;
    const int part = tid >> 6, rho_s = part & 3;
    LAS unsigned char* wdst = lds + part * 1024 + (tid & 63) * 16;
    const int u_m = (r32 >> 4) & 1, hi_m = (r32 >> 2) & 1, j_m = (r32 & 3) + 4 * ((r32 >> 3) & 1), rho_m = 2 * hi_m + u_m;
    LAS unsigned char* krd = lds + rho_m * 1024 + (hi * 8 + j_m) * 16;
    LAS unsigned char* vrd = lds + 4096 + (2 * hi) * 1024 + r32 * 16;
    const int nit = xo ? 16 : (4096 - bid + G - 1) / G;
    bf16x8 W[12]; u32x4 QR[4];
#define DG_ITEM(I, BH, GR) const int u__##BH = xo ? myr + 32 * (I) : bid + G * (I); const int BH = xo ? xcd * 32 + (u__##BH >> 4) : (u__##BH >> 4), GR = u__##BH & 15
#define DG_PREFETCH(I) do { DG_ITEM(I, bh_, g_); \
        const bf16_t* src_ = ((part < 4) ? Kb : Vt) + (size_t)bh_ * (16 * 32 * 512) + (size_t)rho_s * (32 * 512) + (tid & 63) * 8; \
        _Pragma("unroll") for (int t = 0; t < 12; ++t) { const int w_ = 2 * g_ - 1 + (t >> 2); W[t] = *(const bf16x8*)(src_ + (size_t)((t & 3) * 4 * 32 + (w_ < 0 ? 0 : w_)) * 512); } \
        const bf16_t* qb_ = Q + ((size_t)(bh_ >> 4) * SEQ) * DM + (bh_ & 15) * HD; \
        _Pragma("unroll") for (int k = 0; k < 4; ++k) QR[k] = __builtin_nontemporal_load((const u32x4*)(qb_ + (size_t)((8 * g_ + wave) * 32 + 8 * k + (lane >> 3)) * DM + (lane & 7) * 8)); } while (0)
    if (nit > 0) DG_PREFETCH(0);
    for (int it = 0; it < nit; ++it) {
        DG_ITEM(it, bh, g);
        const int b = bh >> 4, h = bh & 15, blk = 8 * g + wave, tq = 32 * blk + r32;
        const size_t rowbase = (size_t)b * SEQ;
        ATT_WAITBAR();
#pragma unroll
        for (int t = 0; t < 12; ++t) *(lds_v8)(wdst + t * 8192) = W[t];
#pragma unroll
        for (int k = 0; k < 4; ++k) *(LAS u32x4*)(scr + (8 * k + (lane >> 3)) * SCR_PITCH + (lane & 7) * 16) = QR[k];
        ATT_WAITBAR();
        if (it + 1 < nit) DG_PREFETCH(it + 1);
        bf16x8 qf[4];
#pragma unroll
        for (int s = 0; s < 4; ++s) qf[s] = *(LAS bf16x8*)(scr + r32 * SCR_PITCH + (2 * s + hi) * 16);
        f32x16 o0 = {}, o1 = {}; float mrun = -1e30f, l = 0.f;
        for (int t = 4 * vlo; t < 4 * vlo + 8; ++t) {
            const int v = t >> 2, a = t & 3, w = 2 * g - 1 + v, slot = t * 8192;
            if (w < 0) continue;
            bf16x8 KF[4], VF[4];
#pragma unroll
            for (int s = 0; s < 4; ++s) KF[s] = *(lds_v8)(krd + slot + s * 256);
            VF[0] = *(lds_v8)(vrd + slot); VF[1] = *(lds_v8)(vrd + slot + 1024); VF[2] = *(lds_v8)(vrd + slot + 512); VF[3] = *(lds_v8)(vrd + slot + 1024 + 512);
            f32x16 S = {};
#pragma unroll
            for (int s = 0; s < 4; ++s) S = __builtin_amdgcn_mfma_f32_32x32x16_bf16(KF[s], qf[s], S, 0, 0, 0);
            const int dA = tq - 128 * w - 4 * a - 2 * hi, dB = dA - 1;
            float z[16];
#pragma unroll
            for (int i = 0; i < 16; ++i) { const bool ok = (unsigned)(((i >> 3) ? dB : dA) - 16 * (i & 7)) <= 128u; z[i] = ok ? S[i] : -INFINITY; }
            float mx = __builtin_fmaxf(__builtin_fmaxf(__builtin_fmaxf(__builtin_fmaxf(z[0], z[1]), __builtin_fmaxf(z[2], z[3])), __builtin_fmaxf(__builtin_fmaxf(z[4], z[5]), __builtin_fmaxf(z[6], z[7]))),
                                       __builtin_fmaxf(__builtin_fmaxf(__builtin_fmaxf(z[8], z[9]), __builtin_fmaxf(z[10], z[11])), __builtin_fmaxf(__builtin_fmaxf(z[12], z[13]), __builtin_fmaxf(z[14], z[15]))));
            auto rr = __builtin_amdgcn_permlane32_swap(__float_as_uint(mx), __float_as_uint(mx), false, false);
            mx = fmaxf(__uint_as_float(rr[0]), __uint_as_float(rr[1]));
            if (__ballot(mx > mrun) != 0ull) { const float mnew = fmaxf(mrun, mx); const float alpha = __builtin_amdgcn_exp2f(mrun - mnew); mrun = mnew; l *= alpha;
#pragma unroll
                for (int i = 0; i < 16; ++i) { o0[i] *= alpha; o1[i] *= alpha; } }
            float p[16];
#pragma unroll
            for (int i = 0; i < 16; ++i) p[i] = __builtin_amdgcn_exp2f(z[i] - mrun);
            l += (((p[0] + p[1]) + (p[2] + p[3])) + ((p[4] + p[5]) + (p[6] + p[7]))) + (((p[8] + p[9]) + (p[10] + p[11])) + ((p[12] + p[13]) + (p[14] + p[15])));
            const bf16x8 p0 = pack8(p), p1 = pack8(p + 8);
            o0 = __builtin_amdgcn_mfma_f32_32x32x16_bf16(VF[0], p0, o0, 0, 0, 0); o0 = __builtin_amdgcn_mfma_f32_32x32x16_bf16(VF[1], p1, o0, 0, 0, 0);
            o1 = __builtin_amdgcn_mfma_f32_32x32x16_bf16(VF[2], p0, o1, 0, 0, 0); o1 = __builtin_amdgcn_mfma_f32_32x32x16_bf16(VF[3], p1, o1, 0, 0, 0);
        }
        auto rr = __builtin_amdgcn_permlane32_swap(__float_as_uint(l), __float_as_uint(l), false, false);
        const float lt = __uint_as_float(rr[0]) + __uint_as_float(rr[1]);
        o_to_lds(scr, o0, o1, 1.0f / lt, r32, hi);
        lds_to_rows(scr, X1 + rowbase * DM + h * HD, 32 * blk, 1, lane);
        if (hi == 0) LSE[(rowbase + tq) * 16 + h] = mrun + __builtin_amdgcn_logf(lt);
    }
#undef DG_ITEM
#undef DG_PREFETCH
}

#define GAS __attribute__((address_space(1)))
__device__ __forceinline__ unsigned xb_ld(unsigned* p)              { return __hip_atomic_load(p, __ATOMIC_RELAXED, __HIP_MEMORY_SCOPE_AGENT); }
__device__ __forceinline__ unsigned xb_add(unsigned* p, unsigned v) { return __hip_atomic_fetch_add(p, v, __ATOMIC_RELAXED, __HIP_MEMORY_SCOPE_AGENT); }
#define XB_TMO      128
#define XB_XCNT(j)  (256  + 64 * (j))
#define XB_XSUB(j)  (1280 + 64 * (j))
#define XB_XGEN(j)  (2304 + 64 * (j))
#define XB_TOP      3328
#define XB_TOPGEN   3392
#define XCD_BAR_WORDS 3456
#define XB_SPIN_CAP (1u << 18)

__device__ __forceinline__ unsigned xb_xcc_id() { return (unsigned)__builtin_amdgcn_s_getreg((3 << 11) | 20) & 0xFu; }
#define XB_SPIN(cond, bar) do { unsigned _sp = 0; while (cond) { __builtin_amdgcn_s_sleep(1); \
    if ((++_sp & 255u) == 0u) { if (xb_ld(&(bar)[XB_TMO])) break; if (_sp > XB_SPIN_CAP) { atomicAdd(&(bar)[XB_TMO], 1u); break; } } } } while (0)

struct XcdBarrier {
    unsigned* bar; unsigned x;
    volatile LAS unsigned* st;
};

__device__ __forceinline__ XcdBarrier xcd_barrier_post(unsigned* bar, volatile LAS unsigned* st) {
    XcdBarrier b; b.bar = bar; b.x = xb_xcc_id(); b.st = st;
    if (threadIdx.x == 0) st[2] = xb_add(&bar[XB_XCNT(b.x)], 1u);
    return b;
}
__device__ __forceinline__ void xcd_barrier_complete(unsigned* bar, unsigned x, unsigned& nloc, unsigned& nx) {
    const unsigned G = gridDim.x * gridDim.y * gridDim.z;
    unsigned sum, cnt, mine, sp = 0u;
    for (;;) {
        sum = 0u; cnt = 0u; mine = 0u;
#pragma unroll
        for (unsigned j = 0; j < 16; ++j) { const unsigned c = xb_ld(&bar[XB_XCNT(j)]); sum += c; cnt += (c > 0u) ? 1u : 0u; mine = (j == x) ? c : mine; }
        if (sum == G) break;
        __builtin_amdgcn_s_sleep(1);
        if ((++sp & 255u) == 0u) { if (xb_ld(&bar[XB_TMO])) break; if (sp > XB_SPIN_CAP) { atomicAdd(&bar[XB_TMO], 1u); break; } }
    }
    nloc = mine > 0u ? mine : 1u; nx = cnt > 0u ? cnt : 1u;
}

__device__ __forceinline__ void xcd_barrier(const XcdBarrier& b) {
    asm volatile("s_waitcnt vmcnt(0)" ::: "memory");
    __syncthreads();
    if (threadIdx.x == 0) {
        unsigned* bar = b.bar;
        __builtin_amdgcn_s_waitcnt(0);
        unsigned nloc = b.st[0], nx = b.st[1];
        if (nloc == 0u) { xcd_barrier_complete(bar, b.x, nloc, nx); b.st[0] = nloc; b.st[1] = nx; }
        const unsigned old = xb_add(&bar[XB_XSUB(b.x)], 1u);
        const unsigned gen = old / nloc;
        if (old + 1u == (gen + 1u) * nloc) {
            __builtin_amdgcn_fence(__ATOMIC_RELEASE, "agent");
            asm volatile("s_waitcnt vmcnt(0)" ::: "memory");
            const unsigned og = xb_add(&bar[XB_TOP], 1u);
            const unsigned tg = og / nx;
            if (og + 1u == (tg + 1u) * nx) xb_add(&bar[XB_TOPGEN], 1u);
            else XB_SPIN(xb_ld(&bar[XB_TOPGEN]) == tg, bar);
            __builtin_amdgcn_fence(__ATOMIC_ACQUIRE, "agent");
            xb_add(&bar[XB_XGEN(b.x)], 1u);
            asm volatile("s_waitcnt vmcnt(0)" ::: "memory");
        } else {
            XB_SPIN(xb_ld(&bar[XB_XGEN(b.x)]) == gen, bar);
            __builtin_amdgcn_fence(__ATOMIC_ACQUIRE, "agent");
            asm volatile("s_waitcnt vmcnt(0)" ::: "memory");
        }
    }
    __syncthreads();
}

__global__ void __launch_bounds__(512) yoco_fwd(Args a) {
    extern __shared__ __attribute__((aligned(16))) unsigned char lds_raw[];
    LAS unsigned char* lds = (LAS unsigned char*)lds_raw;
    cg::grid_group grid = cg::this_grid();
    if (threadIdx.x < 4) ((volatile LAS unsigned*)(lds + BARW_OFF))[threadIdx.x] = 0u;
    __syncthreads();
    if (blockIdx.x == 0) { unsigned* bz = (unsigned*)(a.ws + WS_BAR); for (int i = threadIdx.x; i < (int)(BAR_BYTES / 4); i += 512) bz[i] = 0u; }
    XcdBarrier xbar; xbar.bar = (unsigned*)(a.ws + WS_BAR); xbar.x = 0; xbar.st = (volatile LAS unsigned*)(lds + BARW_OFF);
    for (int ph = a.ph_lo; ph < a.ph_hi; ++ph) {
        const int L_ = (ph - 1) / 5, sub_ = (ph - 1) % 5; const bool mid = ph > 0 && ph < NPHASE - 1;
        int nrep = 1;
        if ((PROBE == 1 || PROBE == 8) && mid && sub_ == 1 && L_ < 2) nrep = 2;
        if (PROBE == 3 && mid && sub_ == 3) nrep = 2;
        if (PROBE == 4 && mid && sub_ == 0) nrep = 2;
        if (PROBE == 5 && ph == 3) nrep = 2;
        if ((PROBE == 13 || PROBE == 16) && ph == 1) nrep = 2;
        if (PROBE == 14 && ph == 11) nrep = 2;
        if (PROBE == 15 && ph == 16) nrep = 2;
        if (PROBE == 6 && ph == 0) nrep = 2;
        for (int rep = 0; rep < nrep; ++rep) {
        int tid = threadIdx.x; asm volatile("" : "+v"(tid));
        int bid = blockIdx.x, G = gridDim.x; asm volatile("" : "+s"(bid), "+s"(G));
        const int lane = tid & 63, wave = __builtin_amdgcn_readfirstlane(tid >> 6), gw = bid * 8 + wave, ngw = G * 8;
        ArgsP ap = (ArgsP)__builtin_amdgcn_kernarg_segment_ptr(); asm volatile("" : "+s"(ap));
        unsigned char* ws = ap->ws;
        float* ssqA = (float*)(ws + WS_SSQ); float* ssqB = ssqA; const float* rope = (const float*)(ws + WS_ROPE);
        bf16_t* hb = (bf16_t*)(ws + WS_HB); bf16_t* qo = (bf16_t*)(ws + WS_QO); bf16_t* kb = (bf16_t*)(ws + WS_K); bf16_t* vt = (bf16_t*)(ws + WS_VT); bf16_t* act = (bf16_t*)(ws + WS_ACT);
        bf16_t* odst = (rep + 1 < nrep) ? act : qo;
        if (PROBE == 7 && rep == 0 && ph > 0) grid.sync();
        if (ph == 0) prologue(ap, lds, gw, ngw, wave, lane);
        else if (ph == NPHASE - 1) final_norm(ap, gw, ngw, lane);
        else {
            const int L = (ph - 1) / 5, sub = (ph - 1) % 5;
            if (sub == 0) {
                const bf16_t* W = (L < 2) ? (const bf16_t*)(ws + WS_WQKV_A + L * SZ_WQKV) : (L == 2 ? (const bf16_t*)(ws + WS_WB2) : (const bf16_t*)(ws + WS_WB3));
                const int N = (L == 3) ? 1024 : 3072;
                pg8::Gemm g{hb, W, MTOK, N, DM}; pg8::StaticOrder S; S.init(MTOK, N, G, bid);
                if (L < 2) { pg8::EpiQKV<0> E{qo, kb, vt, ssqB, rope}; pg8::gemm_phase<pg8::EpiQKV<0>, pg8::StaticOrder, true, true>(lds, g, S, E); }
                else { pg8::EpiQKV<1> E{qo, kb, vt, ssqB, rope}; pg8::gemm_phase<pg8::EpiQKV<1>, pg8::StaticOrder, true, true>(lds, g, S, E); }
            } else if (sub == 1) {
                if (L < 2) {
                    sb_groups(qo, kb, vt, odst, bid, G, tid, lds);
                } else {
                    bf16_t* x1 = act; float* lse = (float*)(ws + WS_ACT + 128 * MiB);
                    bool xo = (G == 256); { unsigned* bw = (unsigned*)(ws + WS_BAR);
#pragma unroll
                        for (int j = 0; j < 16; ++j) xo = xo && (xb_ld(&bw[XB_XCNT(j)]) == (j < 8 ? 32u : 0u)); }
                    const int myx = (int)xb_xcc_id(), myr = (int)((volatile LAS unsigned*)(lds + BARW_OFF))[2];
                    const int wpx = xo ? 256 : ngw, vw = xo ? myr * 8 + wave : gw, xcd = xo ? myx : 0, nun = xo ? 4096 : 32768;
                    dil_groups0(qo, kb, vt, x1, lse, xo, xcd, myr, bid, G, tid, lds);
                    if (PROBE == 9 || PROBE == 10) { int t3 = threadIdx.x; asm volatile("" : "+v"(t3)); const int lane3 = t3 & 63;
                        for (int u = vw; u < nun; u += wpx) { const int bh = xcd * 32 + (u >> 7), rem = u & 127; dil_unit<0>(qo, kb, vt, qo, x1 + 136 * MiB / 2, lse + 66 * MiB, bh, 0, rem, lane3, lds + SCR_OFF + wave * SCR_BYTES, PROBE == 9 ? 64 : 2); } }
                    if (PROBE == 12) { int t3 = threadIdx.x; asm volatile("" : "+v"(t3));
                        if (xo) { for (int u = myr; u < 512; u += 32) dil_group0(qo, kb, vt, x1 + 136 * MiB / 2, lse + 66 * MiB, xcd * 32 + (u >> 4), u & 15, t3, lds); }
                        else { for (int u = bid; u < 4096; u += G) dil_group0(qo, kb, vt, x1 + 136 * MiB / 2, lse + 66 * MiB, u >> 4, u & 15, t3, lds); } }
                    xcd_barrier(xbar);
                    if (PROBE == 11) { int t4 = threadIdx.x; asm volatile("" : "+v"(t4)); const int lane4 = t4 & 63;
                        for (int u = vw; u < nun; u += wpx) { const int bh = xcd * 32 + (u >> 7), rem = u & 127; dil_unit<1>(qo, kb, vt, x1 + 136 * MiB / 2, x1, lse, bh, rem & 15, rem >> 4, lane4, lds + SCR_OFF + wave * SCR_BYTES); } }
                    { int t2 = threadIdx.x; asm volatile("" : "+v"(t2)); const int lane2 = t2 & 63;
                    for (int u = vw; u < nun; u += wpx) { const int bh = xcd * 32 + (u >> 7), rem = u & 127; dil_unit<1>(qo, kb, vt, qo, x1, lse, bh, rem & 15, rem >> 4, lane2, lds + SCR_OFF + wave * SCR_BYTES); } }
                }
            } else if (sub == 2) {
                const bf16_t* W = (L < 2) ? (const bf16_t*)(ws + WS_WO_A + L * SZ_WSQ) : (const bf16_t*)(ws + WS_WO_B + (L - 2) * SZ_WSQ);
                pg8::Gemm g{qo, W, MTOK, DM, DM}; pg8::StaticOrder S; S.init(MTOK, DM, G, bid);
                pg8::EpiRes E{hb, ssqA};
                pg8::gemm_phase<pg8::EpiRes, pg8::StaticOrder, true, true>(lds, g, S, E);
            } else if (sub == 3) {
                pg8::Gemm g{hb, (const bf16_t*)(ws + WS_WGU + L * SZ_WGU), MTOK, 2 * DFF, DM}; pg8::StaticOrder S; S.init(MTOK, 2 * DFF, G, bid);
                pg8::EpiSwiGLU E{act, ssqA};
                pg8::gemm_phase<pg8::EpiSwiGLU, pg8::StaticOrder, true, true>(lds, g, S, E);
            } else {
                pg8::Gemm g{act, (const bf16_t*)(ws + WS_WDN + L * SZ_WDN), MTOK, DM, DFF}; pg8::StaticOrder S; S.init(MTOK, DM, G, bid);
                pg8::EpiRes E{hb, ssqB};
                pg8::gemm_phase<pg8::EpiRes, pg8::StaticOrder, true, true>(lds, g, S, E);
            }
        }
        }
        if (ph + 1 < a.ph_hi) { if (ph == a.ph_lo) { grid.sync(); xbar = xcd_barrier_post((unsigned*)(a.ws + WS_BAR), (volatile LAS unsigned*)(lds + BARW_OFF)); } else xcd_barrier(xbar); }
    }
}

#ifndef N_LAUNCHES
#define N_LAUNCHES 1
#endif
extern "C" void kernel_launch(void* const* d_in, const int* in_sizes, int n_in, void* d_out, int out_size, void* d_ws, size_t ws_size, hipStream_t stream) {
    static int grid = 0;
    if (grid == 0) {
        if (n_in != 13 || in_sizes[0] != MTOK * DM || out_size != MTOK * DM || ws_size < WS_END) { fprintf(stderr, "kernel_launch: unexpected shapes / workspace (n_in %d, ws %zu)\n", n_in, ws_size); grid = -1; return; }
        int dev = 0, cus = 0, per_cu = 0;
        (void)hipGetDevice(&dev); (void)hipDeviceGetAttribute(&cus, hipDeviceAttributeMultiprocessorCount, dev);
        if (hipFuncSetAttribute((const void*)yoco_fwd, hipFuncAttributeMaxDynamicSharedMemorySize, LDS_BYTES) != hipSuccess) { fprintf(stderr, "kernel_launch: hipFuncSetAttribute failed\n"); grid = -1; return; }
        if (hipOccupancyMaxActiveBlocksPerMultiprocessor(&per_cu, (const void*)yoco_fwd, 512, LDS_BYTES) != hipSuccess || per_cu < 1) per_cu = 1;
        (void)hipGetLastError();
        grid = cus * per_cu;
        if (grid > 256) grid = 256;
    }
    if (grid < 0) return;
    Args a{};
    for (int i = 0; i < 13; ++i) a.in[i] = (const float*)d_in[i];
    a.out = (float*)d_out; a.ws = (unsigned char*)d_ws;
    if (N_LAUNCHES == 1) {
        a.ph_lo = 0; a.ph_hi = NPHASE;
        void* kargs[] = {&a};
        hipError_t e = hipLaunchCooperativeKernel((const void*)yoco_fwd, dim3(grid), dim3(512), kargs, LDS_BYTES, stream);
        if (e != hipSuccess) fprintf(stderr, "cooperative launch failed: %s (grid %d)\n", hipGetErrorString(e), grid);
    } else {
        for (int ph = 0; ph < NPHASE; ++ph) { a.ph_lo = ph; a.ph_hi = ph + 1; hipLaunchKernelGGL(yoco_fwd, dim3(grid), dim3(512), LDS_BYTES, stream, a); }
    }
}
```
